# Optimizing an MI355X kernel written in HIP

```python
import math
import jax, jax.numpy as jnp
from jax import lax
import numpy as np

D_MODEL = 1024
BATCH = 16
SEQ = 4096
DEPTH = 4

N_MIXERS = 2
N_DIFF_LAYERS = (DEPTH + 1) // 2
N_RET_LAYERS = DEPTH // 2

DIFF_HEADS = 8
DIFF_HEAD_DIM = D_MODEL // DIFF_HEADS // 2
DIFF_V_DIM = 2 * DIFF_HEAD_DIM
DIFF_Q_BLOCK = 128

RET_HEADS = 4
RET_QK_DIM = D_MODEL // RET_HEADS
RET_V_DIM = 2 * RET_QK_DIM
RET_VALUE_WIDTH = RET_HEADS * RET_V_DIM
RET_CHUNK = 128

N_EXPERTS = 32
TOP_K = 4
EXPERT_FF = D_MODEL
SWIGLU_ALPHA = 1.702
SWIGLU_LIMIT = 7.0

NORM_EPS = 1e-5

kernel_name = "hybrid_diffattn_retention_moe_encoder"


def rms_norm(x, gain=None, eps=NORM_EPS):
    xf = x.astype(jnp.float32)
    y = xf * lax.rsqrt(jnp.mean(xf * xf, axis=-1, keepdims=True) + eps)
    if gain is not None:
        y = y * gain.astype(jnp.float32)
    return y.astype(x.dtype)


def alibi_slopes(n_heads):
    return jnp.exp2(-8.0 * jnp.arange(1, n_heads + 1, dtype=jnp.float32) / n_heads)


def lambda_init_fn(layer_idx):
    return 0.8 - 0.6 * math.exp(-0.3 * layer_idx)


def diff_attention(h, w_in, w_out, lq1, lk1, lq2, lk2, q_gain, k_gain, subln_gain, lambda_init):
    B_, S_, _ = h.shape
    H, dh, QB = DIFF_HEADS, DIFF_HEAD_DIM, DIFF_Q_BLOCK
    qkv = h @ w_in
    q, k, v = jnp.split(qkv, 3, axis=-1)
    q = rms_norm(q.reshape(B_, S_, H, 2, dh), q_gain) * (dh ** -0.5)
    k = rms_norm(k.reshape(B_, S_, H, 2, dh), k_gain)
    v = v.reshape(B_, S_, H, DIFF_V_DIM)
    lam = (jnp.exp(jnp.sum(lq1.astype(jnp.float32) * lk1.astype(jnp.float32)))
           - jnp.exp(jnp.sum(lq2.astype(jnp.float32) * lk2.astype(jnp.float32)))
           + lambda_init)
    slopes = alibi_slopes(H)[:, None, None, None]
    key_pos = jnp.arange(S_, dtype=jnp.float32)
    nb = S_ // QB
    q_blocks = q.reshape(B_, nb, QB, H, 2, dh).transpose(1, 0, 2, 3, 4, 5)
    starts = jnp.arange(nb, dtype=jnp.int32) * QB

    def block(args):
        qb, start = args
        s = jnp.einsum('bqhcd,bkhcd->bhcqk', qb, k).astype(jnp.float32)
        q_pos = (start + jnp.arange(QB, dtype=jnp.int32)).astype(jnp.float32)
        dist = jnp.abs(q_pos[:, None] - key_pos[None, :])
        s = s - slopes * dist[None, None]
        p = jax.nn.softmax(s, axis=-1)
        a = (p[:, :, 0] - lam * p[:, :, 1]).astype(v.dtype)
        return jnp.einsum('bhqk,bkhd->bqhd', a, v)

    o = lax.map(block, (q_blocks, starts))
    o = o.transpose(1, 0, 2, 3, 4).reshape(B_, S_, H, DIFF_V_DIM)
    o = rms_norm(o, subln_gain) * (1.0 - lambda_init)
    return o.reshape(B_, S_, H * DIFF_V_DIM) @ w_out


def retention_scan(q, k, v, log_g, strict):
    B_, S_, H, dk = q.shape
    dv = v.shape[-1]
    C = RET_CHUNK
    nc = S_ // C

    def chunks(t):
        return t.reshape(B_, nc, C, H, t.shape[-1]).transpose(1, 0, 3, 2, 4)

    lg = log_g.astype(jnp.float32)
    idx = jnp.arange(C, dtype=jnp.float32)
    rel = idx[:, None] - idx[None, :]
    mask = rel > 0 if strict else rel >= 0
    d_intra = jnp.where(mask, jnp.exp(lg[:, None, None] * jnp.maximum(rel, 0.0)), 0.0).astype(q.dtype)
    xi = jnp.exp(lg[:, None] * (idx + 1.0))[..., None].astype(q.dtype)
    zeta = jnp.exp(lg[:, None] * (C - 1.0 - idx))[..., None].astype(q.dtype)
    chunk_decay = jnp.exp(lg * C)[:, None, None].astype(q.dtype)

    def step(state, xs):
        qc, kc, vc = xs
        scores = jnp.einsum('bhid,bhjd->bhij', qc, kc) * d_intra
        out = (jnp.einsum('bhij,bhjv->bhiv', scores, vc)
               + jnp.einsum('bhid,bhdv->bhiv', qc, state) * xi)
        state = state * chunk_decay + jnp.einsum('bhjd,bhjv->bhdv', kc * zeta, vc)
        return state, out

    init = jnp.zeros((B_, H, dk, dv), q.dtype)
    _, o = lax.scan(step, init, (chunks(q), chunks(k), chunks(v)))
    return o.transpose(1, 0, 3, 2, 4).reshape(B_, S_, H, dv)


def retention(h, w_in, w_out, log_g_fwd, log_g_bwd):
    B_, S_, _ = h.shape
    H = RET_HEADS
    proj = h @ w_in
    q, k, v, g = jnp.split(proj, [D_MODEL, 2 * D_MODEL, 2 * D_MODEL + RET_VALUE_WIDTH], axis=-1)
    q = q.reshape(B_, S_, H, RET_QK_DIM)
    k = k.reshape(B_, S_, H, RET_QK_DIM) * (RET_QK_DIM ** -0.5)
    v = v.reshape(B_, S_, H, RET_V_DIM)
    o_fwd = retention_scan(q, k, v, log_g_fwd, strict=False)
    o_bwd = jnp.flip(retention_scan(jnp.flip(q, axis=1), jnp.flip(k, axis=1), jnp.flip(v, axis=1),
                                    log_g_bwd, strict=True), axis=1)
    o = rms_norm(o_fwd + o_bwd)
    o = jax.nn.silu(g) * o.reshape(B_, S_, RET_VALUE_WIDTH)
    return o @ w_out


def moe_ffn(h, router_w, router_b, w1, b1, w2, b2):
    logits = (h @ router_w + router_b).astype(jnp.float32)
    vals, idx = lax.top_k(logits, TOP_K)
    wts = jax.nn.softmax(vals, axis=-1)
    gates = jnp.einsum('bske,bsk->bse', jax.nn.one_hot(idx, N_EXPERTS, dtype=jnp.float32), wts).astype(h.dtype)
    out = jnp.zeros_like(h)
    for e in range(N_EXPERTS):
        u = h @ w1[e] + b1[e]
        x_glu = jnp.minimum(u[..., ::2], SWIGLU_LIMIT)
        x_lin = jnp.clip(u[..., 1::2], -SWIGLU_LIMIT, SWIGLU_LIMIT)
        act = x_glu * jax.nn.sigmoid(SWIGLU_ALPHA * x_glu) * (x_lin + 1.0)
        out = out + gates[..., e:e + 1] * (act @ w2[e] + b2[e])
    return out


def setup_inputs(seed: int = 0) -> dict:
    key = jax.random.key(seed)
    ks = jax.random.split(key, 24)
    f32 = jnp.float32
    nd, nr = N_DIFF_LAYERS, N_RET_LAYERS
    D, dh = D_MODEL, DIFF_HEAD_DIM
    out_scale = (2.0 * DEPTH) ** -0.5

    def nrm(k, shape, scale):
        return jax.random.normal(k, shape, f32) * scale

    def gain(k, shape):
        return 1.0 + 0.05 * jax.random.normal(k, shape, f32)

    base_log_decay = jnp.log(1.0 - jnp.exp2(-5.0 - jnp.arange(RET_HEADS, dtype=f32)))
    return {
        "x": jax.random.normal(ks[0], (BATCH, SEQ, D), f32),
        "diff_norm": gain(ks[1], (nd, D)),
        "diff_w_in": nrm(ks[2], (nd, D, 3 * D), D ** -0.5),
        "diff_w_out": nrm(ks[3], (nd, D, D), D ** -0.5 * out_scale),
        "diff_lambda_q1": nrm(ks[4], (nd, dh), 0.1),
        "diff_lambda_k1": nrm(ks[5], (nd, dh), 0.1),
        "diff_lambda_q2": nrm(ks[6], (nd, dh), 0.1),
        "diff_lambda_k2": nrm(ks[7], (nd, dh), 0.1),
        "diff_q_norm": gain(ks[8], (nd, dh)),
        "diff_k_norm": gain(ks[9], (nd, dh)),
        "diff_subln": gain(ks[10], (nd, DIFF_V_DIM)),
        "ret_norm": gain(ks[11], (nr, D)),
        "ret_w_in": nrm(ks[12], (nr, D, 2 * D + 2 * RET_VALUE_WIDTH), D ** -0.5),
        "ret_w_out": nrm(ks[13], (nr, RET_VALUE_WIDTH, D), RET_VALUE_WIDTH ** -0.5 * out_scale),
        "ret_log_decay_fwd": base_log_decay * (1.0 + 0.05 * jax.random.uniform(ks[14], (nr, RET_HEADS), f32, -1.0, 1.0)),
        "ret_log_decay_bwd": base_log_decay * (1.0 + 0.05 * jax.random.uniform(ks[15], (nr, RET_HEADS), f32, -1.0, 1.0)),
        "moe_norm": gain(ks[16], (DEPTH, D)),
        "moe_router_w": nrm(ks[17], (DEPTH, D, N_EXPERTS), D ** -0.5),
        "moe_router_b": nrm(ks[18], (DEPTH, N_EXPERTS), 0.01),
        "moe_w1": nrm(ks[19], (DEPTH, N_EXPERTS, D, 2 * EXPERT_FF), D ** -0.5),
        "moe_b1": nrm(ks[20], (DEPTH, N_EXPERTS, 2 * EXPERT_FF), 0.02),
        "moe_w2": nrm(ks[21], (DEPTH, N_EXPERTS, EXPERT_FF, D), EXPERT_FF ** -0.5 * out_scale),
        "moe_b2": nrm(ks[22], (DEPTH, N_EXPERTS, D), 0.02),
    }


def reference(x, diff_norm, diff_w_in, diff_w_out, diff_lambda_q1, diff_lambda_k1, diff_lambda_q2,
              diff_lambda_k2, diff_q_norm, diff_k_norm, diff_subln, ret_norm, ret_w_in, ret_w_out,
              ret_log_decay_fwd, ret_log_decay_bwd, moe_norm, moe_router_w, moe_router_b,
              moe_w1, moe_b1, moe_w2, moe_b2):
    for i in range(DEPTH):
        j = i // N_MIXERS
        if i % N_MIXERS == 0:
            h = rms_norm(x, diff_norm[j])
            x = x + diff_attention(h, diff_w_in[j], diff_w_out[j], diff_lambda_q1[j], diff_lambda_k1[j],
                                   diff_lambda_q2[j], diff_lambda_k2[j], diff_q_norm[j], diff_k_norm[j],
                                   diff_subln[j], lambda_init_fn(i))
        else:
            h = rms_norm(x, ret_norm[j])
            x = x + retention(h, ret_w_in[j], ret_w_out[j], ret_log_decay_fwd[j], ret_log_decay_bwd[j])
        h = rms_norm(x, moe_norm[i])
        x = x + moe_ffn(h, moe_router_w[i], moe_router_b[i], moe_w1[i], moe_b1[i], moe_w2[i], moe_b2[i])
    return x
```

```cpp
#include <hip/hip_runtime.h>
#include <cstdio>
#include <cstdint>

#define GAS __attribute__((address_space(1)))
#define LAS __attribute__((address_space(3)))
typedef unsigned short bf16;
typedef unsigned v4u __attribute__((ext_vector_type(4)));
typedef unsigned v2u __attribute__((ext_vector_type(2)));
typedef float f32x4 __attribute__((ext_vector_type(4)));
typedef float f32x2 __attribute__((ext_vector_type(2)));
typedef float f32x16 __attribute__((ext_vector_type(16)));
typedef short bf16x8 __attribute__((ext_vector_type(8)));
typedef short s16x4 __attribute__((ext_vector_type(4)));
typedef __bf16 bf16x2_t __attribute__((ext_vector_type(2)));
typedef GAS unsigned gu32;

constexpr int NTOK = 65536, DM = 1024, SEQ = 4096, NBATCH = 16, DEPTH = 4;
constexpr int NEXP = 32, TOPK = 4, FF = 1024;
constexpr int RET_VW = 2048;
constexpr float NORM_EPS = 1e-5f;
constexpr float LOG2E = 1.4426950408889634f;

__device__ __forceinline__ unsigned cvtpk(float lo, float hi) { f32x2 v = {lo, hi}; bf16x2_t b = __builtin_convertvector(v, bf16x2_t); return __builtin_bit_cast(unsigned, b); }
__device__ __forceinline__ float bflo(unsigned u) { return __uint_as_float(u << 16); }
__device__ __forceinline__ float bfhi(unsigned u) { return __uint_as_float(u & 0xffff0000u); }
extern __shared__ __attribute__((aligned(16))) unsigned char lds_raw[];
constexpr int WTAB_BYTES = 147456 + 4 * 192;
__device__ __forceinline__ int lane_now() { int l; asm volatile("v_mbcnt_lo_u32_b32 %0, -1, 0\n\tv_mbcnt_hi_u32_b32 %0, -1, %0" : "=v"(l)); return l; }
__device__ __forceinline__ unsigned hw_wave_slot() { return (unsigned)__builtin_amdgcn_s_getreg((5 << 11) | 4) & 63u; }
__device__ __forceinline__ int opaque_tid() {
    const int w = __builtin_amdgcn_readfirstlane(*(const LAS int*)((LAS unsigned char*)lds_raw + WTAB_BYTES + 4 * hw_wave_slot()));
    int t = w * 64 + lane_now(); asm volatile("" : "+v"(t)); return t; }
__device__ __forceinline__ float shfl_xor_(float v, int m, int lane) { return __uint_as_float((unsigned)__builtin_amdgcn_ds_bpermute((lane ^ m) << 2, (int)__float_as_uint(v))); }
__device__ __forceinline__ float shfl_idx_(float v, int idx) { return __uint_as_float((unsigned)__builtin_amdgcn_ds_bpermute(idx << 2, (int)__float_as_uint(v))); }
template <class T> __device__ __forceinline__ T* opaque_ptr(T* p) { asm volatile("" : "+s"(p)); return p; }
__device__ __forceinline__ float wave_sum(float v) {
    const int l_ = lane_now();
#pragma unroll
    for (int o = 1; o < 64; o <<= 1) v += shfl_xor_(v, o, l_);
    return v;
}

namespace pg8 {
constexpr int BM = 256, BK = 64, HALF = 128, HTB = HALF * BK * 2  , STAGE_BYTES = 8 * HTB;

__host__ __device__ __forceinline__ int lds_byte(int r, int c) { const int st = (r >> 4) * 2 + (c >> 5), rr = r & 15, cc = c & 31, ob = rr * 64 + cc * 2; return st * 1024 + (ob ^ (((ob >> 9) & 1) << 5)); }
__host__ __device__ __forceinline__ void stage_rc(int b, int& R, int& C) { const int st = b / 1024, sb = b % 1024, swz = sb ^ (((sb >> 9) & 1) << 5); R = (st >> 1) * 16 + swz / 64; C = (st & 1) * 32 + (swz % 64) / 2; }
__host__ __device__ __forceinline__ int perm32(int rho) { const int n = rho >> 4, i = rho & 15; return 8 * (i >> 2) + 4 * n + (i & 3); }

typedef int v8i __attribute__((ext_vector_type(8)));
__device__ __forceinline__ v8i cat16(bf16x8 a, bf16x8 b) { const v4u x = __builtin_bit_cast(v4u, a), y = __builtin_bit_cast(v4u, b); return (v8i){(int)x.x, (int)x.y, (int)x.z, (int)x.w, (int)y.x, (int)y.y, (int)y.z, (int)y.w}; }
__device__ __forceinline__ void mfma_fp8_acc(f32x4& c, v8i a, v8i b, int sc1) {
    asm volatile("v_mfma_scale_f32_16x16x128_f8f6f4 %0, %1, %2, %0, %3, %3 op_sel_hi:[0,0,0]" : "+v"(c) : "v"(a), "v"(b), "v"(sc1));
}
constexpr int TEXP_REL = 8192 - 64;
constexpr int LISTPARK_OFF = 147456 + 4096;
constexpr int PARK_OFF = 147456 + 12288;
__device__ __forceinline__ void glds4(const GAS void* gsrc, unsigned lds_dst) { unsigned keep;
    asm volatile("s_mov_b32 %0, m0\n\ts_mov_b32 m0, %2\n\ts_nop 0\n\tglobal_load_lds_dword %1, off\n\ts_mov_b32 m0, %0" : "=&s"(keep) : "v"(gsrc), "s"(lds_dst) : "memory"); }
struct Unit { int pm, pn, e, lt; };

__device__ __forceinline__ void order_map(long L, int nN, int& pm, int& pn) {
    const int grp = (int)(L >> 5), w = (int)(L & 31), ncg = nN >> 2;
    pm = (grp / ncg) * 8 + (w & 7); pn = (grp % ncg) * 4 + (w >> 3);
}

template <int K_, int BMODE_, bool FP8_ = false> struct DenseProb {
    static constexpr int K = K_, BMODE = BMODE_, PB = FP8_ ? K_ : 2 * K_; static constexpr bool GATHER = false, FP8 = FP8_;
    const void* A; const void* Bt; int nM, nN, G, c;
    __device__ __forceinline__ bool next(int i, Unit& u) const {
        const long L = (long)i * G + c; if (L >= (long)nM * nN) return false;
        order_map(L, nN, u.pm, u.pn); u.e = 0; u.lt = 0; return true; }
    __device__ __forceinline__ const char* a_base(const Unit& u) const { return (const char*)A + (size_t)u.pm * ((size_t)BM * PB); }
    __device__ __forceinline__ const char* b_base(const Unit& u) const { return (const char*)Bt + (size_t)u.pn * ((size_t)BM * PB); }
    template <int NH> __device__ __forceinline__ void a_rows(const Unit&, int, unsigned (&)[NH][2]) const {}
    __device__ __forceinline__ void pre_rows(const Unit&, int, int, unsigned) const {}
    template <int NH> __device__ __forceinline__ void a_rows_lds(const Unit&, unsigned, unsigned (&)[NH][2], const LAS int*) const {}
};
template <int K_, bool GATHER_, int BMODE_> struct MoeProb {
    static constexpr int K = K_, BMODE = BMODE_, PB = K_; static constexpr bool GATHER = GATHER_, FP8 = true;
    const unsigned char* A; const unsigned char* Bt; size_t bstride;
    const int* list; const int* cnt; const LAS int* toff; int nN, G, c;
    __device__ __forceinline__ bool next(int i, Unit& u) const {
        const int TM = toff[32], TM8 = (TM + 7) & ~7; const long L = (long)i * G + c; if (L >= (long)TM8 * nN) return false;
        int gm, pn; order_map(L, nN, gm, pn); if (gm >= TM) gm = TM - 1;
        const int e = __builtin_amdgcn_readfirstlane((int)((const LAS unsigned char*)toff + TEXP_REL)[gm]);
        u.pm = gm; u.pn = pn; u.e = e; u.lt = gm - toff[e]; return true; }
    __device__ __forceinline__ const char* a_base(const Unit& u) const { return GATHER ? (const char*)A : (const char*)A + (size_t)u.pm * ((size_t)BM * PB); }
    __device__ __forceinline__ const char* b_base(const Unit& u) const { return (const char*)Bt + (size_t)u.e * bstride + (size_t)u.pn * ((size_t)BM * PB); }
    __device__ __forceinline__ void pre_rows(const Unit& u, int wid, int lane, unsigned park) const {
        if (wid < 4) glds4((const GAS void*)(list + (size_t)u.e * NTOK + u.lt * 256 + 64 * wid + lane), park + 256u * (unsigned)wid); }
    template <int NH> __device__ __forceinline__ void a_rows_lds(const Unit& u, unsigned c2, unsigned (&off)[NH][2], const LAS int* park) const {
        const int n = toff[128 + u.e] - u.lt * 256;
        int R, C; stage_rc(opaque_tid() * 16, R, C);
#pragma unroll
        for (int h = 0; h < NH; ++h)
#pragma unroll
            for (int i = 0; i < 2; ++i) { const int idx = h * 128 + i * 64 + R; int tok = park[idx]; if (idx >= n) tok = 0;
                off[h][i] = (unsigned)tok * (unsigned)PB + c2; }
    }
    template <int NH> __device__ __forceinline__ void a_rows(const Unit& u, int tid, unsigned (&off)[NH][2]) const {
        const int n = ((const GAS int*)cnt)[u.e]; const GAS int* le = (const GAS int*)list + (size_t)u.e * NTOK;
        asm volatile("" : "+v"(tid));
#pragma unroll
        for (int h = 0; h < NH; ++h)
#pragma unroll
            for (int i = 0; i < 2; ++i) { int R, C; stage_rc(tid * 16 + i * 8192, R, C); int pos = u.lt * 256 + h * 128 + R; if (pos >= n) pos = 0; const int tok = le[pos]; off[h][i] = (unsigned)tok * (unsigned)PB + (unsigned)(C * 2); }
    }
};

template <class Prob, class Epi, bool ALIGN_EPI>
__device__ __forceinline__ void gemm_phase(LAS unsigned char* lds, const Prob& S, const Epi& E) {
    const int tid = opaque_tid(), wid = __builtin_amdgcn_readfirstlane(tid >> 6), lane = tid & 63, wr = wid >> 2, wc = wid & 3, fr = lane & 15, fq = lane >> 4;
    constexpr int PB = Prob::PB, nt = PB / 128;
    constexpr int NH = Prob::GATHER ? 2 : 1;
    unsigned voffB[2], coffA[NH][2], noffA[NH][2];
    constexpr size_t kstep = (size_t)(BK * 2);
    constexpr size_t hstepA = (size_t)HALF * PB;
    constexpr size_t hstepB = (size_t)(Prob::BMODE == 2 ? 32 : (Prob::BMODE == 3 ? 8 : HALF)) * PB;
#pragma unroll
    for (int i = 0; i < 2; ++i) { int R, C; stage_rc(tid * 16 + i * 8192, R, C);
        const int Rb = Prob::BMODE == 0 ? R : (Prob::BMODE == 1 ? ((R & ~31) + perm32(R & 31)) : (Prob::BMODE == 2 ? (64 * (R >> 5) + perm32(R & 31)) : (64 * (R >> 5) + 16 * ((R & 15) >> 2) + 4 * ((R >> 4) & 1) + (R & 3))));
        voffB[i] = (unsigned)(Rb * PB + C * 2);
#pragma unroll
        for (int h = 0; h < NH; ++h) { coffA[h][i] = (unsigned)(R * PB + C * 2); noffA[h][i] = coffA[h][i]; } }
    const unsigned ldsw = (unsigned)wid * 1024u;
    const int aoff = lds_byte(wr * 64 + fr, fq * 8), boff = lds_byte(wc * 32 + fr, fq * 8);
#define PG8_SA(b, h) (((b) * 2 + (h)) * HTB)
#define PG8_SB(b, h) ((4 + (b) * 2 + (h)) * HTB)
#define PG8_STAGE_A(bufoff, gbase, h, arr) do { _Pragma("unroll") for (int _i = 0; _i < 2; ++_i) \
        __builtin_amdgcn_global_load_lds((const unsigned*)((const char*)(gbase) + (Prob::GATHER ? (size_t)0 : (size_t)(h) * hstepA) + (arr)[Prob::GATHER ? (h) : 0][_i]), (LAS unsigned*)(lds + (bufoff) + ldsw + _i * 8192), 16, 0, 0); } while (0)
#define PG8_STAGE(bufoff, gbase, voff) do { _Pragma("unroll") for (int _i = 0; _i < 2; ++_i) \
        __builtin_amdgcn_global_load_lds((const unsigned*)((const char*)(gbase) + (voff)[_i]), (LAS unsigned*)(lds + (bufoff) + ldsw + _i * 8192), 16, 0, 0); } while (0)
#define PG8_LDA(dst, b, h) do { _Pragma("unroll") for (int m = 0; m < 4; ++m) _Pragma("unroll") for (int k = 0; k < 2; ++k) dst[m][k] = *(const LAS bf16x8*)(lds + PG8_SA(b, h) + aoff + m * 2048 + k * 1024); } while (0)
#define PG8_LDB(dst, b, h) do { _Pragma("unroll") for (int n = 0; n < 2; ++n) _Pragma("unroll") for (int k = 0; k < 2; ++k) dst[n][k] = *(const LAS bf16x8*)(lds + PG8_SB(b, h) + boff + n * 2048 + k * 1024); } while (0)
#define PG8_MMA(ai, bj, At, Bt) do { __builtin_amdgcn_s_setprio(1); _Pragma("unroll") for (int m = 0; m < 4; ++m) _Pragma("unroll") for (int n = 0; n < 2; ++n) { \
        if constexpr (Prob::FP8) mfma_fp8_acc(acc[ai][bj][m][n], cat16(Bt[n][0], Bt[n][1]), cat16(At[m][0], At[m][1]), sc1); \
        else { _Pragma("unroll") for (int k = 0; k < 2; ++k) acc[ai][bj][m][n] = __builtin_amdgcn_mfma_f32_16x16x32_bf16(Bt[n][k], At[m][k], acc[ai][bj][m][n], 0, 0, 0); } } \
        __builtin_amdgcn_s_setprio(0); } while (0)
#define PG8_WAIT_V(n) asm volatile("s_waitcnt vmcnt(" #n ")" ::: "memory")
#define PG8_WAIT_L(n) asm volatile("s_waitcnt lgkmcnt(" #n ")" ::: "memory")
#define PG8_BAR __builtin_amdgcn_s_barrier()
#define PG8_SCHED __builtin_amdgcn_sched_barrier(0)
    int sc1 = 0x7f7f7f7f; asm volatile("" : "+v"(sc1));
    Unit cur, nxt; int ui = 0;
    if (!S.next(0, cur)) return;
    if constexpr (Epi::PARK) E.pre(cur, wid, lane, (unsigned)__builtin_amdgcn_readfirstlane((unsigned)(size_t)(lds + PARK_OFF)));
    f32x4 acc[2][2][4][2];
#pragma unroll
    for (int a = 0; a < 2; ++a)
#pragma unroll
        for (int b = 0; b < 2; ++b)
#pragma unroll
            for (int m = 0; m < 4; ++m)
#pragma unroll
                for (int n = 0; n < 2; ++n) acc[a][b][m][n] = (f32x4){0.f, 0.f, 0.f, 0.f};
    bf16x8 At[4][2], B0[2][2], B1[2][2];
    const char* cA = S.a_base(cur); const char* cB = S.b_base(cur);
    if constexpr (Prob::GATHER) { S.template a_rows<NH>(cur, tid, coffA); PG8_WAIT_V(0); }
    PG8_STAGE(PG8_SB(0, 0), cB, voffB); PG8_STAGE(PG8_SB(0, 1), cB + hstepB, voffB); PG8_STAGE_A(PG8_SA(0, 0), cA, 0, coffA); PG8_STAGE_A(PG8_SA(0, 1), cA, 1, coffA);
    if (wr == 1) PG8_BAR;
    PG8_WAIT_V(2); PG8_BAR;
    PG8_STAGE(PG8_SB(1, 0), cB + kstep, voffB); PG8_STAGE_A(PG8_SA(1, 0), cA + kstep, 0, coffA); PG8_STAGE(PG8_SB(1, 1), cB + hstepB + kstep, voffB);
    PG8_WAIT_V(6); PG8_BAR;
    for (;;) {
        const bool has_next = S.next(ui + 1, nxt);
        const char* nA = has_next ? S.a_base(nxt) : cA; const char* nB = has_next ? S.b_base(nxt) : cB;
        if constexpr (Prob::GATHER) {
            { Unit n2; if (S.next(ui + 2, n2)) S.pre_rows(n2, wid, lane, (unsigned)__builtin_amdgcn_readfirstlane((unsigned)(size_t)(lds + LISTPARK_OFF + ((ui + 2) % 3) * 1024))); }
            if (has_next) {
                if (ui == 0) { S.template a_rows<NH>(nxt, tid, noffA); PG8_WAIT_V(0); }
                else S.template a_rows_lds<NH>(nxt, coffA[0][0] & (unsigned)(PB - 1), noffA, (const LAS int*)(lds + LISTPARK_OFF + ((ui + 1) % 3) * 1024)); }
            else {
#pragma unroll
                for (int h = 0; h < NH; ++h)
#pragma unroll
                    for (int i = 0; i < 2; ++i) noffA[h][i] = coffA[h][i]; }
        }
#pragma unroll 1
        for (int t = 0; t < nt; t += 2) {
            const bool last = (t == nt - 2);
#ifdef DRAIN_PROBE
            if (Prob::FP8 && t == nt / 2) PG8_WAIT_V(0);
#endif
            const char* a1 = cA + (size_t)(t + 1) * kstep;
            const char* a2 = last ? nA : cA + (size_t)(t + 2) * kstep; const char* b2 = last ? nB : cB + (size_t)(t + 2) * kstep;
            const char* a3 = a2 + kstep; const char* b3 = b2 + kstep;
            PG8_LDB(B0, 0, 0); PG8_LDB(B1, 0, 1); PG8_SCHED; PG8_LDA(At, 0, 0); PG8_STAGE_A(PG8_SA(1, 1), a1, 1, coffA);
            if constexpr (Prob::GATHER) { if (last) {
#pragma unroll
                for (int h = 0; h < NH; ++h)
#pragma unroll
                    for (int i = 0; i < 2; ++i) coffA[h][i] = noffA[h][i]; } }
            PG8_WAIT_V(8); PG8_WAIT_L(0); PG8_BAR; PG8_MMA(0, 0, At, B0); PG8_MMA(0, 1, At, B1); PG8_BAR; PG8_SCHED;
            PG8_LDA(At, 0, 1); PG8_STAGE(PG8_SB(0, 0), b2, voffB); PG8_STAGE(PG8_SB(0, 1), b2 + hstepB, voffB); PG8_STAGE_A(PG8_SA(0, 0), a2, 0, coffA);
            PG8_WAIT_V(8); PG8_WAIT_L(0); PG8_BAR; PG8_MMA(1, 0, At, B0); PG8_MMA(1, 1, At, B1); PG8_BAR; PG8_SCHED;
            PG8_LDB(B0, 1, 0); PG8_LDB(B1, 1, 1); PG8_SCHED; PG8_LDA(At, 1, 0); PG8_STAGE_A(PG8_SA(0, 1), a2, 1, coffA);
            PG8_WAIT_V(8); PG8_WAIT_L(0); PG8_BAR; PG8_MMA(0, 0, At, B0); PG8_MMA(0, 1, At, B1); PG8_BAR; PG8_SCHED;
            PG8_LDA(At, 1, 1); PG8_STAGE(PG8_SB(1, 0), b3, voffB); PG8_STAGE(PG8_SB(1, 1), b3 + hstepB, voffB); PG8_STAGE_A(PG8_SA(1, 0), a3, 0, coffA);
            PG8_WAIT_V(8); PG8_WAIT_L(0); PG8_BAR; PG8_MMA(1, 0, At, B0); PG8_MMA(1, 1, At, B1); PG8_BAR; PG8_SCHED;
        }
        if constexpr (Prob::FP8) asm volatile("s_nop 15\n\ts_nop 15" ::: "memory");
        if constexpr (ALIGN_EPI) { if (wr == 0) PG8_BAR; }
        if constexpr (Epi::PARK) E(acc, cur, wr, wc, fr, fq, (const LAS float*)(lds + PARK_OFF + (ui & 1) * 2048)); else E(acc, cur, wr, wc, fr, fq);
        if (!has_next) break;
#pragma unroll
        for (int a = 0; a < 2; ++a)
#pragma unroll
            for (int b = 0; b < 2; ++b)
#pragma unroll
                for (int m = 0; m < 4; ++m)
#pragma unroll
                    for (int n = 0; n < 2; ++n) acc[a][b][m][n] = (f32x4){0.f, 0.f, 0.f, 0.f};
        cur = nxt; cA = nA; cB = nB; ++ui;
        if constexpr (Epi::PARK) E.pre(cur, wid, lane, (unsigned)__builtin_amdgcn_readfirstlane((unsigned)(size_t)(lds + PARK_OFF + (ui & 1) * 2048)));
        if constexpr (Prob::GATHER) {
#pragma unroll
            for (int h = 0; h < NH; ++h)
#pragma unroll
                for (int i = 0; i < 2; ++i) coffA[h][i] = noffA[h][i]; }
        if constexpr (ALIGN_EPI) { if (wr == 1) PG8_BAR; }
    }
    PG8_WAIT_V(0);
    if constexpr (!ALIGN_EPI) { if (wr == 0) PG8_BAR; }
    PG8_BAR;
#undef PG8_SA
#undef PG8_SB
#undef PG8_STAGE
#undef PG8_STAGE_A
#undef PG8_LDA
#undef PG8_LDB
#undef PG8_MMA
#undef PG8_WAIT_V
#undef PG8_WAIT_L
#undef PG8_BAR
#undef PG8_SCHED
}
}

#ifndef Y_FP8
#define Y_FP8 1
#endif
constexpr float Y8_SCALE = 16.0f, ACT8_SCALE = 4.0f;
namespace pg8 {
struct EpiQKV {
    static constexpr bool PARK = true;
    bf16* Qo; bf16* Ko; bf16* Vo; const float* qg; const float* kg; float sc;
    __device__ __forceinline__ void pre(const Unit& u, int wid, int lane, unsigned park) const {
        if (wid == 0 && u.pn < 8) glds4((const GAS void*)((u.pn < 4 ? qg : kg) + lane), park); }
    __device__ __forceinline__ void operator()(const f32x4 (&acc)[2][2][4][2], const Unit& u, int wr, int wc, int fr, int fq, const LAS float* park) const {
        const int sec = u.pn >> 2; const int colt = (u.pn & 3) * 256 + wc * 64 + 8 * fq;
        bf16* base = Qo + (size_t)sec * ((size_t)NTOK * DM);
        const int row0 = u.pm * 256 + wr * 64 + fr;
        const float sc = sec == 0 ? (0.125f * LOG2E) : 1.f;
        f32x4 gv[2][2];
#pragma unroll
        for (int bj = 0; bj < 2; ++bj)
#pragma unroll
            for (int n = 0; n < 2; ++n) gv[bj][n] = sec < 2 ? *(const LAS f32x4*)(park + 32 * bj + 8 * fq + 4 * n) : (f32x4){1.f, 1.f, 1.f, 1.f};
#pragma unroll
        for (int ai = 0; ai < 2; ++ai)
#pragma unroll
            for (int m = 0; m < 4; ++m) {
                float rs = 1.f;
                if (sec < 2) { float ss = 0.f;
#pragma unroll
                    for (int bj = 0; bj < 2; ++bj)
#pragma unroll
                        for (int n = 0; n < 2; ++n) { const f32x4 x = acc[ai][bj][m][n]; ss += (x[0] * x[0] + x[1] * x[1]) + (x[2] * x[2] + x[3] * x[3]); }
                    { const int l_ = lane_now(); ss += shfl_xor_(ss, 16, l_); ss += shfl_xor_(ss, 32, l_); }
                    rs = __builtin_amdgcn_rsqf(ss * (sc * sc * (1.0f / 64.0f)) + NORM_EPS) * sc; }
                bf16* rowp = base + (size_t)(row0 + ai * 128 + m * 16) * DM + colt;
#pragma unroll
                for (int bj = 0; bj < 2; ++bj) { f32x4 g0 = (f32x4){sc, sc, sc, sc}, g1 = g0;
                    if (sec < 2) { g0 = gv[bj][0] * (rs * sc); g1 = gv[bj][1] * (rs * sc); }
                    const f32x4 v0 = acc[ai][bj][m][0] * g0, v1 = acc[ai][bj][m][1] * g1;
                    v4u w; w.x = cvtpk(v0[0], v0[1]); w.y = cvtpk(v0[2], v0[3]); w.z = cvtpk(v1[0], v1[1]); w.w = cvtpk(v1[2], v1[3]);
                    *(GAS v4u*)(rowp + 32 * bj) = w; }
                asm volatile("" ::: "memory");
            }
    }
};
struct EpiRetIn {
    static constexpr bool PARK = false;
    bf16 *Qo, *KFo, *KBo, *Vo, *Go; const float* lgf; const float* lgb; float sc;
    __device__ __forceinline__ void operator()(const f32x4 (&acc)[2][2][4][2], const Unit& u, int wr, int wc, int fr, int fq) const {
        const int pn = u.pn; const int row0 = u.pm * 256 + wr * 64 + fr; const int cw = wc * 32 + 8 * fq;
        if (pn >= 4 && pn < 8) {
            const int hd = pn - 4; const float lf = ((const GAS float*)lgf)[hd], lb = ((const GAS float*)lgb)[hd];
            float zf[2], zb[2];
#pragma unroll
            for (int mm = 0; mm < 2; ++mm) { const float i32 = (float)(16 * mm + fr); zf[mm] = __expf(lf * (31.0f - i32)) * 0.0625f * sc; zb[mm] = __expf(lb * i32) * 0.0625f * sc; }
#pragma unroll
            for (int ai = 0; ai < 2; ++ai)
#pragma unroll
                for (int m = 0; m < 4; ++m) { const size_t off = (size_t)(row0 + ai * 128 + m * 16) * 1024 + hd * 256 + cw;
#pragma unroll
                    for (int bj = 0; bj < 2; ++bj) { const f32x4 a0 = acc[ai][bj][m][0], a1 = acc[ai][bj][m][1]; const float f = zf[m & 1], b = zb[m & 1];
                        v4u w; w.x = cvtpk(a0[0] * f, a0[1] * f); w.y = cvtpk(a0[2] * f, a0[3] * f); w.z = cvtpk(a1[0] * f, a1[1] * f); w.w = cvtpk(a1[2] * f, a1[3] * f);
                        *(GAS v4u*)(KFo + off + 128 * bj) = w;
                        w.x = cvtpk(a0[0] * b, a0[1] * b); w.y = cvtpk(a0[2] * b, a0[3] * b); w.z = cvtpk(a1[0] * b, a1[1] * b); w.w = cvtpk(a1[2] * b, a1[3] * b);
                        *(GAS v4u*)(KBo + off + 128 * bj) = w; } }
        } else {
            bf16* base; int ld, ct;
            if (pn < 4) { base = Qo; ld = 1024; ct = pn; } else if (pn < 16) { base = Vo; ld = 2048; ct = pn - 8; } else { base = Go; ld = 2048; ct = pn - 16; }
#pragma unroll
            for (int ai = 0; ai < 2; ++ai)
#pragma unroll
                for (int m = 0; m < 4; ++m) { bf16* rowp = base + (size_t)(row0 + ai * 128 + m * 16) * ld + ct * 256 + cw;
#pragma unroll
                    for (int bj = 0; bj < 2; ++bj) { const f32x4 a0 = acc[ai][bj][m][0] * sc, a1 = acc[ai][bj][m][1] * sc;
                        v4u w; w.x = cvtpk(a0[0], a0[1]); w.y = cvtpk(a0[2], a0[3]); w.z = cvtpk(a1[0], a1[1]); w.w = cvtpk(a1[2], a1[3]);
                        *(GAS v4u*)(rowp + 128 * bj) = w; } }
        }
    }
};
struct EpiResid {
    static constexpr bool PARK = false;
    const float* resid; float* out;
    __device__ __forceinline__ void operator()(const f32x4 (&acc)[2][2][4][2], const Unit& u, int wr, int wc, int fr, int fq) const {
        const int row0 = u.pm * 256 + wr * 64 + fr, col0 = u.pn * 256 + wc * 32 + 4 * fq;
#pragma unroll
        for (int ai = 0; ai < 2; ++ai)
#pragma unroll
            for (int m = 0; m < 4; ++m) { const size_t off = (size_t)(row0 + ai * 128 + m * 16) * DM + col0;
                f32x4 r[2][2];
#pragma unroll
                for (int bj = 0; bj < 2; ++bj)
#pragma unroll
                    for (int n = 0; n < 2; ++n) r[bj][n] = *(const GAS f32x4*)(resid + off + bj * 128 + n * 16);
#pragma unroll
                for (int bj = 0; bj < 2; ++bj)
#pragma unroll
                    for (int n = 0; n < 2; ++n) *(GAS f32x4*)(out + off + bj * 128 + n * 16) = r[bj][n] + acc[ai][bj][m][n];
                if (m & 1) asm volatile("" ::: "memory"); }
    }
};
struct EpiDelta {
    static constexpr bool PARK = false;
    bf16* d; float sc;
    __device__ __forceinline__ void operator()(const f32x4 (&acc)[2][2][4][2], const Unit& u, int wr, int wc, int fr, int fq) const {
        const int row0 = u.pm * 256 + wr * 64 + fr, c0 = u.pn * 256 + wc * 32 + 8 * fq;
        v4u old[2][4][2];
#pragma unroll
        for (int ai = 0; ai < 2; ++ai)
#pragma unroll
            for (int m = 0; m < 4; ++m)
#pragma unroll
                for (int bj = 0; bj < 2; ++bj) old[ai][m][bj] = *(const GAS v4u*)(d + (size_t)(row0 + ai * 128 + m * 16) * DM + c0 + 128 * bj);
#pragma unroll
        for (int ai = 0; ai < 2; ++ai) {
#pragma unroll
            for (int m = 0; m < 4; ++m) { bf16* rowp = d + (size_t)(row0 + ai * 128 + m * 16) * DM + c0;
#pragma unroll
                for (int bj = 0; bj < 2; ++bj) { const f32x4 a0 = acc[ai][bj][m][0] * sc, a1 = acc[ai][bj][m][1] * sc; const v4u o = old[ai][m][bj];
                    v4u w; w.x = cvtpk(a0[0] + bflo(o.x), a0[1] + bfhi(o.x)); w.y = cvtpk(a0[2] + bflo(o.y), a0[3] + bfhi(o.y)); w.z = cvtpk(a1[0] + bflo(o.z), a1[1] + bfhi(o.z)); w.w = cvtpk(a1[2] + bflo(o.w), a1[3] + bfhi(o.w));
                    *(GAS v4u*)(rowp + 128 * bj) = w; } } }
    }
};
__device__ __forceinline__ float swiglu1(float g, float l) {
    g = fminf(g, 7.0f); l = fminf(fmaxf(l, -7.0f), 7.0f);
    const float s = __builtin_amdgcn_rcpf(1.0f + __builtin_amdgcn_exp2f(-1.702f * LOG2E * g));
    return g * s * (l + 1.0f);
}
constexpr float SWC = -1.702f * LOG2E;
__device__ __forceinline__ float swiglu_c(float cg, float l) {
    cg = fmaxf(cg, 7.0f * SWC); l = fminf(fmaxf(l, -7.0f), 7.0f);
    const float s = __builtin_amdgcn_rcpf(1.0f + __builtin_amdgcn_exp2f(cg));
    return (cg * s) * fmaf(l, ACT8_SCALE / SWC, ACT8_SCALE / SWC);
}
__device__ __forceinline__ f32x2 swiglu_c2(f32x2 cg, f32x2 l) {
    cg = (f32x2){fmaxf(cg.x, 7.0f * SWC), fmaxf(cg.y, 7.0f * SWC)}; l = (f32x2){fminf(fmaxf(l.x, -7.0f), 7.0f), fminf(fmaxf(l.y, -7.0f), 7.0f)};
    const f32x2 d = (f32x2){__builtin_amdgcn_exp2f(cg.x), __builtin_amdgcn_exp2f(cg.y)} + (f32x2){1.0f, 1.0f};
    const f32x2 s = (f32x2){__builtin_amdgcn_rcpf(d.x), __builtin_amdgcn_rcpf(d.y)};
    constexpr float K = ACT8_SCALE / SWC;
    return (cg * s) * __builtin_elementwise_fma(l, (f32x2){K, K}, (f32x2){K, K});
}
__device__ __forceinline__ unsigned pack_fp8x4(float a, float b, float c, float d) { int w = 0; w = __builtin_amdgcn_cvt_pk_fp8_f32(a, b, w, false); w = __builtin_amdgcn_cvt_pk_fp8_f32(c, d, w, true); return (unsigned)w; }
struct EpiSwiglu {
    static constexpr bool PARK = true;
    unsigned char* act; const float* b1; const float* lrs; float sc;
    __device__ __forceinline__ void pre(const Unit& u, int wid, int lane, unsigned park) const {
        if (wid < 4) glds4((const GAS void*)(b1 + (size_t)u.e * 2048 + u.pn * 256 + 64 * wid + lane), park + 256u * (unsigned)wid);
        else glds4((const GAS void*)(lrs + (size_t)u.e * NTOK + u.lt * 256 + 64 * (wid - 4) + lane), park + 1024u + 256u * (unsigned)(wid - 4)); }
    __device__ __forceinline__ void operator()(const f32x4 (&acc)[2][2][4][2], const Unit& u, int wr, int wc, int fr, int fq, const LAS float* park) const {
        const int row0 = u.pm * 256 + wr * 64 + fr; const int c0 = u.pn * 256 + wc * 64 + 16 * fq;
        f32x4 bv[2][2];
#pragma unroll
        for (int bj = 0; bj < 2; ++bj)
#pragma unroll
            for (int n = 0; n < 2; ++n) bv[bj][n] = *(const LAS f32x4*)(park + wc * 64 + 16 * fq + 8 * bj + 4 * n) * (f32x4){SWC, 1.f, SWC, 1.f};
        float rsv[2][4];
        { const LAS float* rp = park + 256 + wr * 64 + fr;
#pragma unroll
          for (int ai = 0; ai < 2; ++ai)
#pragma unroll
              for (int m = 0; m < 4; ++m) rsv[ai][m] = sc * rp[ai * 128 + m * 16]; }
#pragma unroll
        for (int ai = 0; ai < 2; ++ai)
#pragma unroll
            for (int m = 0; m < 4; ++m) { unsigned char* rowp = act + (size_t)(row0 + ai * 128 + m * 16) * FF + (c0 >> 1);
                const float rs = rsv[ai][m]; const f32x2 rs2 = (f32x2){rs * SWC, rs};
                v2u w;
#pragma unroll
                for (int bj = 0; bj < 2; ++bj) { const f32x4 a0 = acc[ai][bj][m][0], a1 = acc[ai][bj][m][1]; const f32x4 b0 = bv[bj][0], b1_ = bv[bj][1];
                    const f32x2 p0 = __builtin_elementwise_fma((f32x2){a0[0], a0[1]}, rs2, (f32x2){b0[0], b0[1]}), p1 = __builtin_elementwise_fma((f32x2){a0[2], a0[3]}, rs2, (f32x2){b0[2], b0[3]});
                    const f32x2 p2 = __builtin_elementwise_fma((f32x2){a1[0], a1[1]}, rs2, (f32x2){b1_[0], b1_[1]}), p3 = __builtin_elementwise_fma((f32x2){a1[2], a1[3]}, rs2, (f32x2){b1_[2], b1_[3]});
                    const f32x2 o01 = swiglu_c2((f32x2){p0.x, p1.x}, (f32x2){p0.y, p1.y}), o23 = swiglu_c2((f32x2){p2.x, p3.x}, (f32x2){p2.y, p3.y});
                    const unsigned p = pack_fp8x4(o01.x, o01.y, o23.x, o23.y);
                    if (bj == 0) w.x = p; else w.y = p; }
                *(GAS v2u*)rowp = w; }
    }
};
struct EpiBias {
    static constexpr bool PARK = true;
    void* y; const float* b2; float sc;
    __device__ __forceinline__ void pre(const Unit& u, int wid, int lane, unsigned park) const {
        if (wid < 4) glds4((const GAS void*)(b2 + (size_t)u.e * 1024 + u.pn * 256 + 64 * wid + lane), park + 256u * (unsigned)wid); }
    __device__ __forceinline__ void operator()(const f32x4 (&acc)[2][2][4][2], const Unit& u, int wr, int wc, int fr, int fq, const LAS float* park) const {
        const int row0 = u.pm * 256 + wr * 64 + fr; const int c0 = u.pn * 256 + wc * 32 + 8 * fq;
        f32x4 bv[2][2];
#pragma unroll
        for (int bj = 0; bj < 2; ++bj)
#pragma unroll
            for (int n = 0; n < 2; ++n) bv[bj][n] = *(const LAS f32x4*)(park + wc * 32 + 8 * fq + bj * 128 + 4 * n) * (Y_FP8 ? Y8_SCALE : 1.0f);
        const float scy = sc * (Y_FP8 ? Y8_SCALE : 1.0f);
#pragma unroll
        for (int ai = 0; ai < 2; ++ai)
#pragma unroll
            for (int m = 0; m < 4; ++m) { const size_t ro = (size_t)(row0 + ai * 128 + m * 16) * DM + c0;
#pragma unroll
                for (int bj = 0; bj < 2; ++bj) { const f32x4 v0 = acc[ai][bj][m][0] * scy + bv[bj][0], v1 = acc[ai][bj][m][1] * scy + bv[bj][1];
                    if (Y_FP8) { v2u w; w.x = pack_fp8x4(v0[0], v0[1], v0[2], v0[3]); w.y = pack_fp8x4(v1[0], v1[1], v1[2], v1[3]);
                        *(GAS v2u*)((unsigned char*)y + ro + 128 * bj) = w; }
                    else { v4u w; w.x = cvtpk(v0[0], v0[1]); w.y = cvtpk(v0[2], v0[3]); w.z = cvtpk(v1[0], v1[1]); w.w = cvtpk(v1[2], v1[3]);
                        *(GAS v4u*)((bf16*)y + ro + 128 * bj) = w; } } }
    }
};
}

constexpr size_t MiB = 1u << 20;
constexpr size_t WS_CTL = 0, CTL_ZERO_BYTES = 1 * MiB;
constexpr size_t WS_WDI = 2 * MiB, WS_WDO = 14 * MiB, WS_WRI = 18 * MiB, WS_WRO = 42 * MiB, WS_W1 = 50 * MiB, WS_W2 = 562 * MiB;
constexpr size_t WS_HB = 818 * MiB;
constexpr size_t WS_PROJ = 946 * MiB;
constexpr size_t WS_AO = 1842 * MiB;
constexpr size_t WS_ROF = 1970 * MiB, WS_ROB = 2226 * MiB, WS_RGO = 2482 * MiB, WS_RP = 2738 * MiB;
constexpr size_t WS_ACT = 2754 * MiB, WS_Y = 3282 * MiB;
constexpr float H8U_SCALE = 4.0f;
constexpr float AO8_SCALE = 8.0f, WDO_SCALE = 128.0f;
constexpr float H8_SCALE = 8.0f, W1_SCALE = 64.0f, W2_SCALE = 128.0f, WRI_SCALE = 64.0f, WRO_SCALE = 128.0f, GO8_SCALE = 4.0f;
constexpr size_t WS_LIST = 3810 * MiB, WS_TSLOT = 3818 * MiB, WS_TGATE = 3819 * MiB, WS_HB8 = 3820 * MiB, WS_XB = 3884 * MiB, WS_WRT = 4012 * MiB, WS_LRS = 4013 * MiB, WS_END = 4021 * MiB;
constexpr int WRP = 1032;
constexpr int CW_BAR = 4096, CW_CNT = 8192;
constexpr int RING_BYTES = 147456, MISC_OFF = RING_BYTES, LDS_BYTES = 163840;

#define RLX_AGENT __ATOMIC_RELAXED, __HIP_MEMORY_SCOPE_AGENT
#define XB_TMO      128
#define XB_XCNT(j)  (256  + 64 * (j))
#define XB_XSUB(j)  (1280 + 64 * (j))
#define XB_XGEN(j)  (2304 + 64 * (j))
#define XB_TOP      3328
#define XB_TOPGEN   3392
#define XCD_BAR_WORDS 3456
#define XB_SPIN_CAP (1u << 18)

__device__ __forceinline__ unsigned xb_ld(unsigned* p)              { return __hip_atomic_load(p, __ATOMIC_RELAXED, __HIP_MEMORY_SCOPE_AGENT); }
__device__ __forceinline__ unsigned xb_add(unsigned* p, unsigned v) { return __hip_atomic_fetch_add(p, v, __ATOMIC_RELAXED, __HIP_MEMORY_SCOPE_AGENT); }
__device__ __forceinline__ unsigned xb_xcc_id() { return (unsigned)__builtin_amdgcn_s_getreg((3 << 11) | 20) & 0xFu; }
#define XB_SPIN(cond, bar) do { unsigned _sp = 0; while (cond) { __builtin_amdgcn_s_sleep(1); \
    if ((++_sp & 255u) == 0u) { if (xb_ld(&(bar)[XB_TMO])) break; if (_sp > XB_SPIN_CAP) { atomicAdd(&(bar)[XB_TMO], 1u); break; } } } } while (0)

struct XcdBarrier {
    unsigned* bar; unsigned x;
    volatile LAS unsigned* st;
};

__device__ __forceinline__ XcdBarrier xcd_barrier_post(unsigned* bar, volatile LAS unsigned* st) {
    XcdBarrier b; b.bar = bar; b.x = xb_xcc_id(); b.st = st;
    if (opaque_tid() == 0) (void)xb_add(&bar[XB_XCNT(b.x)], 1u);
    return b;
}
__device__ __forceinline__ void xcd_barrier_complete(unsigned* bar, unsigned x, unsigned& nloc, unsigned& nx) {
    const unsigned G = gridDim.x * gridDim.y * gridDim.z;
    unsigned sum, cnt, mine, sp = 0u;
    for (;;) {
        sum = 0u; cnt = 0u; mine = 0u;
#pragma unroll
        for (unsigned j = 0; j < 16; ++j) { const unsigned c = xb_ld(&bar[XB_XCNT(j)]); sum += c; cnt += (c > 0u) ? 1u : 0u; mine = (j == x) ? c : mine; }
        if (sum == G) break;
        __builtin_amdgcn_s_sleep(1);
        if ((++sp & 255u) == 0u) { if (xb_ld(&bar[XB_TMO])) break; if (sp > XB_SPIN_CAP) { atomicAdd(&bar[XB_TMO], 1u); break; } }
    }
    nloc = mine > 0u ? mine : 1u; nx = cnt > 0u ? cnt : 1u;
}

__device__ __forceinline__ void xcd_barrier(const XcdBarrier& b) {
    asm volatile("s_waitcnt vmcnt(0)" ::: "memory");
    __syncthreads();
    if (opaque_tid() == 0) {
        unsigned* bar = b.bar;
        __builtin_amdgcn_s_waitcnt(0);
        unsigned nloc = b.st[0], nx = b.st[1];
        if (nloc == 0u) { xcd_barrier_complete(bar, b.x, nloc, nx); b.st[0] = nloc; b.st[1] = nx; }
        const unsigned old = xb_add(&bar[XB_XSUB(b.x)], 1u);
        const unsigned gen = old / nloc;
        if (old + 1u == (gen + 1u) * nloc) {
            __builtin_amdgcn_fence(__ATOMIC_RELEASE, "agent");
            asm volatile("s_waitcnt vmcnt(0)" ::: "memory");
            const unsigned og = xb_add(&bar[XB_TOP], 1u);
            const unsigned tg = og / nx;
            if (og + 1u == (tg + 1u) * nx) xb_add(&bar[XB_TOPGEN], 1u);
            else XB_SPIN(xb_ld(&bar[XB_TOPGEN]) == tg, bar);
            __builtin_amdgcn_fence(__ATOMIC_ACQUIRE, "agent");
            xb_add(&bar[XB_XGEN(b.x)], 1u);
            asm volatile("s_waitcnt vmcnt(0)" ::: "memory");
        } else {
            XB_SPIN(xb_ld(&bar[XB_XGEN(b.x)]) == gen, bar);
            __builtin_amdgcn_fence(__ATOMIC_ACQUIRE, "agent");
            asm volatile("s_waitcnt vmcnt(0)" ::: "memory");
        }
    }
    __syncthreads();
}

#ifndef ATT_OUT_FP8
#define ATT_OUT_FP8 1
#endif
namespace att {
typedef short v4i16_t __attribute__((ext_vector_type(4)));
constexpr int KSLOT = 8192, VSLOT = 16384;
constexpr int NSLOT = 3;
constexpr int L_K = 0, L_V = NSLOT * KSLOT, L_WS = L_V + NSLOT * VSLOT, L_OST = L_WS + 8 * 512, L_END = L_OST + 8 * 8192;
__device__ __forceinline__ int crow(int r, int hi) { return (r & 3) + 8 * (r >> 2) + 4 * hi; }
__device__ __forceinline__ s16x4 vtr(const LAS char* p) { return __builtin_bit_cast(s16x4, __builtin_amdgcn_ds_read_tr16_b64_v4i16((LAS v4i16_t*)p)); }
__device__ __forceinline__ bf16x8 cat8(s16x4 lo, s16x4 hi) { return (bf16x8){lo[0], lo[1], lo[2], lo[3], hi[0], hi[1], hi[2], hi[3]}; }
__device__ __forceinline__ bf16x8 pack8(const f32x16& p, int s) {
    v4u w; w.x = cvtpk(p[8 * s], p[8 * s + 1]); w.y = cvtpk(p[8 * s + 2], p[8 * s + 3]); w.z = cvtpk(p[8 * s + 4], p[8 * s + 5]); w.w = cvtpk(p[8 * s + 6], p[8 * s + 7]);
    return __builtin_bit_cast(bf16x8, w);
}
__device__ __forceinline__ void glds16(const GAS void* gsrc, unsigned lds_dst) { unsigned keep;
    asm volatile("s_mov_b32 %0, m0\n\ts_mov_b32 m0, %2\n\ts_nop 0\n\tglobal_load_lds_dwordx4 %1, off\n\ts_mov_b32 m0, %0" : "=&s"(keep) : "v"(gsrc), "s"(lds_dst) : "memory"); }
struct AttnArgs { const bf16* Q; const bf16* K; const bf16* V; bf16* O; float lam; const float* subg; float oscale; float qkb; };

__device__ __forceinline__ int tile_seq(int it, int q4, int nl) { return it < 4 ? q4 + it : (it < 4 + nl ? q4 + 3 - it : q4 + it - nl); }

__device__ __forceinline__ void attn_unit(int b, int h, int qb, const AttnArgs& A, LAS char* shm) {
    const int tid = opaque_tid(), lane = tid & 63, r32 = lane & 31, hi = lane >> 5; const int wid = __builtin_amdgcn_readfirstlane(tid >> 6);
    const size_t rowbase = (size_t)b * SEQ;
    const int qw0 = qb * 256 + wid * 32, q4 = qb * 4, qh = qw0 >> 5;
    const float fi = (float)(qw0 + r32);
    const float slope = __builtin_amdgcn_exp2f(-(float)(h + 1)), sl2 = slope * LOG2E;
    constexpr float SKIP_T = 32.0f;
    const int W = (int)fminf((2.0f * A.qkb + SKIP_T) / slope, 8192.0f) + 1;
    const int jlo = max(0, (qb * 256 - W) >> 6), jhi = min(SEQ / 64 - 1, (qb * 256 + 255 + W) >> 6);
    const int NT = jhi - jlo + 1, nl = qb * 4 - jlo;
    const float B2 = A.qkb * LOG2E; const bool fixref = (2.0f * B2 < 100.0f);
    const bf16x8 ones = (bf16x8){0x3F80, 0x3F80, 0x3F80, 0x3F80, 0x3F80, 0x3F80, 0x3F80, 0x3F80};
    const float sl2h = sl2 * (float)(4 * hi);
    LAS float* wsf = (LAS float*)(shm + L_WS) + wid * 128;
#pragma unroll 1
    for (int c = 0; c < 2; ++c) {
        bf16x8 qr[4];
        { const bf16* qu = A.Q + (rowbase + qw0) * DM + h * 128 + c * 64; const unsigned ql = (unsigned)(r32 * DM + hi * 8);
#pragma unroll
          for (int d0 = 0; d0 < 4; ++d0) qr[d0] = *(const GAS bf16x8*)(qu + (ql + d0 * 16));
#pragma unroll
          for (int d0 = 0; d0 < 4; ++d0) asm volatile("" : "+v"(qr[d0])); }
        float m = fixref ? B2 : 0.f; f32x16 o[4], ol;
#pragma unroll
        for (int r = 0; r < 16; ++r) ol[r] = 0.f;
#pragma unroll
        for (int d0 = 0; d0 < 4; ++d0)
#pragma unroll
            for (int r = 0; r < 16; ++r) o[d0][r] = 0.f;
        const bf16* kgu = A.K + rowbase * DM + h * 128 + c * 64 + wid * 8;
        const bf16* vgu = A.V + (rowbase + 16 * (wid & 3)) * DM + h * 128 + 32 * (wid >> 2);
        const unsigned kl = (unsigned)(lane * DM), vl = (unsigned)((lane >> 2) * DM + 8 * (lane & 3));
        const unsigned lds0 = (unsigned)(size_t)shm;
        const unsigned kw = lds0 + L_K + wid * 1024, vw = lds0 + L_V + wid * 1024;
#define ATT_DMA(tile, slot) do { const size_t to_ = (size_t)(tile) * 64 * DM; \
            glds16((const GAS void*)(kgu + to_ + kl), (unsigned)__builtin_amdgcn_readfirstlane(kw + (slot) * KSLOT)); \
            glds16((const GAS void*)(vgu + to_ + vl), (unsigned)__builtin_amdgcn_readfirstlane(vw + (slot) * VSLOT)); \
            glds16((const GAS void*)(vgu + to_ + 64 + vl), (unsigned)__builtin_amdgcn_readfirstlane(vw + (slot) * VSLOT + 8192)); } while (0)
        ATT_DMA(tile_seq(0, q4, nl), 0); ATT_DMA(tile_seq(1, q4, nl), 1);
        asm volatile("s_waitcnt vmcnt(0)\n\ts_barrier" ::: "memory");
        int slot = 0;
#define ATT_QK(PN, jt, hb_, sl_) do { const int kh_ = 2 * (jt) + (hb_); const LAS char* kb_ = shm + L_K + (sl_) * KSLOT + hi * 1024 + r32 * 16 + (hb_) * 512; \
            bf16x8 kf_[4]; _Pragma("unroll") for (int d0 = 0; d0 < 4; ++d0) kf_[d0] = *(const LAS bf16x8*)(kb_ + d0 * 2048); \
            if (kh_ == qh) { const float x0 = (float)(32 * kh_) - fi + (float)(4 * hi); \
                _Pragma("unroll") for (int r = 0; r < 16; ++r) { const float x = x0 + (float)((r & 3) + 8 * (r >> 2)); PN[r] = -sl2 * fabsf(x) - m; } \
            } else if (kh_ < qh) { const float base = sl2 * ((float)(32 * kh_) - fi) - m + sl2h; \
                _Pragma("unroll") for (int r = 0; r < 16; ++r) PN[r] = fmaf(sl2, (float)((r & 3) + 8 * (r >> 2)), base); \
            } else { const float base = sl2 * (fi - (float)(32 * kh_)) - m - sl2h; \
                _Pragma("unroll") for (int r = 0; r < 16; ++r) PN[r] = fmaf(-sl2, (float)((r & 3) + 8 * (r >> 2)), base); } \
            __builtin_amdgcn_sched_barrier(0); \
            _Pragma("unroll") for (int d0 = 0; d0 < 4; ++d0) PN = __builtin_amdgcn_mfma_f32_32x32x16_bf16(kf_[d0], qr[d0], PN, 0, 0, 0); \
            __builtin_amdgcn_sched_barrier(0); } while (0)
        f32x16 pn;
#if defined(ATT_DUP) && (ATT_DUP & 8)
        bf16x8 zfrag_ = (bf16x8){0, 0, 0, 0, 0, 0, 0, 0}; asm volatile("" : "+v"(zfrag_));
#endif
        ATT_QK(pn, tile_seq(0, q4, nl), 0, 0);
#pragma unroll 1
        for (int it = 0; it < NT; ++it) {
            const int j = tile_seq(it, q4, nl), buf = slot, nslot = slot == NSLOT - 1 ? 0 : slot + 1;
            if (it + 2 < NT) { const int s2 = slot >= 1 ? slot - 1 : slot + 2; ATT_DMA(tile_seq(it + 2, q4, nl), s2);
#if defined(ATT_DUP) && (ATT_DUP & 2)
                ATT_DMA(tile_seq(it + 2, q4, nl), s2);
#endif
            }
            const LAS char* vp = shm + L_V + buf * VSLOT + ((lane >> 4) & 1) * 32 + (lane & 3) * 8 + (4 * hi + ((lane & 15) >> 2)) * 64;
#pragma unroll
            for (int hb = 0; hb < 2; ++hb) {
                f32x16 p = pn;
                if (hb == 0) ATT_QK(pn, j, 1, buf);
                else if (it + 1 < NT) ATT_QK(pn, tile_seq(it + 1, q4, nl), 0, nslot);
                s16x4 vk0[8], vk1[8];
#define ATT_VLDK(dst, ks) do { _Pragma("unroll") for (int d0 = 0; d0 < 4; ++d0) { dst[2 * d0] = vtr(vp + d0 * 4096 + (2 * hb + (ks)) * 1024); dst[2 * d0 + 1] = vtr(vp + d0 * 4096 + (2 * hb + (ks)) * 1024 + 512); } } while (0)
                ATT_VLDK(vk0, 0);
                __builtin_amdgcn_sched_barrier(0);
                if (!fixref) {
                    float rm = fmaxf(p[0], p[1]);
#pragma unroll
                    for (int r = 2; r < 16; ++r) rm = fmaxf(rm, p[r]);
                    rm = fmaxf(rm, shfl_xor_(rm, 32, lane_now()));
                    const bool first = (it == 0 && hb == 0);
                    if (first || __any(rm > 6.0f)) {
                        const float dl = first ? rm : fmaxf(rm, 0.f);
                        m += dl;
#pragma unroll
                        for (int r = 0; r < 16; ++r) { p[r] -= dl; pn[r] -= dl; }
                        if (!first) {
                            const float f = __builtin_amdgcn_exp2f(-dl);
                            if (hi == 0) wsf[r32] = f;
#pragma unroll
                            for (int g = 0; g < 4; ++g) { const f32x4 t = *(const LAS f32x4*)(wsf + 8 * g + 4 * hi);
                                ol[4 * g] *= t[0]; ol[4 * g + 1] *= t[1]; ol[4 * g + 2] *= t[2]; ol[4 * g + 3] *= t[3];
#pragma unroll
                                for (int d0 = 0; d0 < 4; ++d0) { o[d0][4 * g] *= t[0]; o[d0][4 * g + 1] *= t[1]; o[d0][4 * g + 2] *= t[2]; o[d0][4 * g + 3] *= t[3]; } }
                        }
                    }
                }
#define EX2(i) do { p[i] = __builtin_amdgcn_exp2f(p[i]); p[(i) + 1] = __builtin_amdgcn_exp2f(p[(i) + 1]); } while (0)
#define SB() __builtin_amdgcn_sched_barrier(0)
#pragma unroll
                for (int r = 0; r < 8; ++r) p[r] = __builtin_amdgcn_exp2f(p[r]);
                const bf16x8 pw0 = pack8(p, 0);
                SB();
                ATT_VLDK(vk1, 1);
                SB();
                __builtin_amdgcn_s_setprio(1);
                ol = __builtin_amdgcn_mfma_f32_32x32x16_bf16(pw0, ones, ol, 0, 0, 0); EX2(8); SB();
                o[0] = __builtin_amdgcn_mfma_f32_32x32x16_bf16(pw0, cat8(vk0[0], vk0[1]), o[0], 0, 0, 0); EX2(10); SB();
                o[1] = __builtin_amdgcn_mfma_f32_32x32x16_bf16(pw0, cat8(vk0[2], vk0[3]), o[1], 0, 0, 0); EX2(12); SB();
                o[2] = __builtin_amdgcn_mfma_f32_32x32x16_bf16(pw0, cat8(vk0[4], vk0[5]), o[2], 0, 0, 0); EX2(14); SB();
                o[3] = __builtin_amdgcn_mfma_f32_32x32x16_bf16(pw0, cat8(vk0[6], vk0[7]), o[3], 0, 0, 0);
                const bf16x8 pw1 = pack8(p, 1);
                SB();
                ol = __builtin_amdgcn_mfma_f32_32x32x16_bf16(pw1, ones, ol, 0, 0, 0);
#pragma unroll
                for (int d0 = 0; d0 < 4; ++d0) o[d0] = __builtin_amdgcn_mfma_f32_32x32x16_bf16(pw1, cat8(vk1[2 * d0], vk1[2 * d0 + 1]), o[d0], 0, 0, 0);
                __builtin_amdgcn_s_setprio(0);
                SB();
#undef EX2
#undef SB
#undef ATT_VLDK
            }
            asm volatile("s_waitcnt vmcnt(0) lgkmcnt(0)\n\ts_barrier" ::: "memory");
            slot = nslot;
        }
#undef ATT_QK
#undef ATT_DMA
        int le = lane; asm volatile("" : "+v"(le));
        const int r32e = le & 31, hie = le >> 5;
        float rl[16];
#pragma unroll
        for (int r = 0; r < 16; ++r) rl[r] = __builtin_amdgcn_rcpf(ol[r]);
        LAS unsigned* svl = (LAS unsigned*)(shm + L_OST + wid * 8192) + le;
        if (c == 0) {
#pragma unroll
            for (int d0 = 0; d0 < 4; ++d0)
#pragma unroll
                for (int r2 = 0; r2 < 8; ++r2) svl[(d0 * 8 + r2) * 64] = cvtpk(o[d0][2 * r2] * rl[2 * r2], o[d0][2 * r2 + 1] * rl[2 * r2 + 1]);
        } else {
            float ss[16];
#pragma unroll
            for (int r = 0; r < 16; ++r) ss[r] = 0.f;
#pragma unroll
            for (int d0 = 0; d0 < 4; ++d0)
#pragma unroll
                for (int r2 = 0; r2 < 8; ++r2) { const unsigned svv = svl[(d0 * 8 + r2) * 64];
                    const float a = bflo(svv) - A.lam * o[d0][2 * r2] * rl[2 * r2], bq = bfhi(svv) - A.lam * o[d0][2 * r2 + 1] * rl[2 * r2 + 1];
                    o[d0][2 * r2] = a; o[d0][2 * r2 + 1] = bq; ss[2 * r2] += a * a; ss[2 * r2 + 1] += bq * bq; }
#pragma unroll
            for (int x = 1; x < 32; x <<= 1) { const int pa = (le ^ x) << 2;
#pragma unroll
                for (int r = 0; r < 16; ++r) ss[r] += __uint_as_float(__builtin_amdgcn_ds_bpermute(pa, __float_as_uint(ss[r]))); }
#pragma unroll
            for (int r = 0; r < 16; ++r) ss[r] = __builtin_amdgcn_rsqf(ss[r] * (1.0f / 128.0f) + NORM_EPS);
            asm volatile("s_waitcnt lgkmcnt(0)" ::: "memory");
#if ATT_OUT_FP8
            LAS unsigned char* stg = (LAS unsigned char*)(shm + L_OST + wid * 8192);
#pragma unroll
            for (int d0 = 0; d0 < 4; ++d0) { const float sg = ((const GAS float*)A.subg)[r32e + 32 * d0] * A.oscale * AO8_SCALE;
#pragma unroll
                for (int r = 0; r < 16; ++r) { const float v_ = o[d0][r] * ss[r] * sg; stg[crow(r, hie) * 128 + d0 * 32 + r32e] = (unsigned char)(__builtin_amdgcn_cvt_pk_fp8_f32(v_, v_, 0, false) & 0xff); } }
            unsigned char* Ow = (unsigned char*)A.O + (rowbase + qw0) * DM + h * 128; const unsigned olo = (unsigned)((le >> 3) * DM + (le & 7) * 16);
#pragma unroll
            for (int i = 0; i < 4; ++i) { const int row = i * 8 + (le >> 3), ch = le & 7; const v4u v = *(const LAS v4u*)(stg + row * 128 + ch * 16); *(GAS v4u*)(Ow + (olo + (unsigned)(i * 8 * DM))) = v; }
#else
            LAS bf16* stg = (LAS bf16*)(shm + L_OST + wid * 8192);
#pragma unroll
            for (int d0 = 0; d0 < 4; ++d0) { const float sg = ((const GAS float*)A.subg)[r32e + 32 * d0] * A.oscale;
#pragma unroll
                for (int r = 0; r < 16; ++r) stg[crow(r, hie) * 128 + d0 * 32 + r32e] = (bf16)(cvtpk(o[d0][r] * ss[r] * sg, 0.f) & 0xffffu); }
            bf16* Ow = A.O + (rowbase + qw0) * DM + h * 128; const unsigned olo = (unsigned)((le >> 4) * DM + (le & 15) * 8);
#pragma unroll
            for (int i = 0; i < 8; ++i) { const int row = i * 4 + (le >> 4), ch = le & 15; const v4u v = *(const LAS v4u*)(stg + row * 128 + ch * 8); *(GAS v4u*)(Ow + (olo + (unsigned)(i * 4 * DM))) = v; }
#endif
        }
    }
}
}

namespace ret {
using att::crow; using att::vtr; using att::cat8; using att::pack8;
constexpr int QPITCH = 520, PPITCH = 72;
constexpr int L_Q = 0, L_KT = 32 * QPITCH, L_VT = L_KT + 16384, L_PT = L_VT + 16384, BUFB = L_PT + 32 * PPITCH;

__device__ __forceinline__ void rp_unit(int b, int h, int sc, const bf16* RQ, const bf16* RKF, const bf16* RKB, bf16* RP, float lgf, float lgb) {
    const int lane = opaque_tid() & 63, r32 = lane & 31, hi = lane >> 5;
    const size_t tb = (size_t)b * SEQ + 32 * sc;
    const size_t ro = (tb + r32) * 1024 + h * 256 + 8 * hi;
    f32x16 pf;
#pragma unroll
    for (int r = 0; r < 16; ++r) pf[r] = 0.f;
#pragma unroll
    for (int ks = 0; ks < 16; ++ks) {
        const bf16x8 a = *(const GAS bf16x8*)(RQ + ro + 16 * ks), kf = *(const GAS bf16x8*)(RKF + ro + 16 * ks);
        pf = __builtin_amdgcn_mfma_f32_32x32x16_bf16(a, kf, pf, 0, 0, 0);
    }
    const float fj = (float)r32, upj = lgf * (fj - 31.0f) + lgb * fj;
#pragma unroll
    for (int r = 0; r < 16; ++r) { const int i = crow(r, hi); const float fi = (float)i;
        const float v = pf[r] * __expf((r32 <= i) ? lgf * (fi - 31.0f) : upj - lgb * fi);
        ((GAS bf16*)RP)[(tb + i) * 128 + h * 32 + r32] = (bf16)(cvtpk(v, 0.f) & 0xffffu); }
}

struct ChainArgs { const bf16* RQ; const bf16* RK; const bf16* RV; const bf16* RP; bf16* OUT; float lg; };

__device__ __forceinline__ void chain_unit(int b, int h, int dir, int vs, const ChainArgs& A, LAS char* shm) {
    const int tid = opaque_tid(), lane = tid & 63, r32 = lane & 31, hi = lane >> 5; const int wid = __builtin_amdgcn_readfirstlane(tid >> 6);
    const float decay = __expf(A.lg * 32.0f);
    const float xiB = __expf(A.lg * (dir == 0 ? (float)(4 * hi + 1) : (float)(32 - 4 * hi))), xiU = __expf(dir == 0 ? A.lg : -A.lg), xiW = __expf(dir == 0 ? 8.0f * A.lg : -8.0f * A.lg);
    f32x16 S[8];
#pragma unroll
    for (int db = 0; db < 8; ++db)
#pragma unroll
        for (int r = 0; r < 16; ++r) S[db][r] = 0.f;
    const int qrow = tid >> 4, qch = tid & 15;
    const bf16* qg = A.RQ + ((size_t)b * SEQ + qrow) * 1024 + h * 256 + qch * 8;
    const int srow = lane >> 2, sch = lane & 3;
    const bf16* kg = A.RK + ((size_t)b * SEQ + 16 * (wid & 1) + srow) * 1024 + h * 256 + 32 * (wid >> 1) + 8 * sch;
    const bf16* vg = A.RV + ((size_t)b * SEQ + 16 * (wid & 1) + srow) * 2048 + h * 512 + vs * 256 + 32 * (wid >> 1) + 8 * sch;
    const bf16* pg = A.RP + ((size_t)b * SEQ + (tid >> 2)) * 128 + h * 32 + (tid & 3) * 8;
    v4u q0, q1, k0, k1, v0, v1, pp;
    pp = (v4u){0u, 0u, 0u, 0u};
#define RET_LOAD(sc) do { const size_t t_ = (size_t)(sc) * 32; \
        q0 = *(const GAS v4u*)(qg + t_ * 1024); q1 = *(const GAS v4u*)(qg + t_ * 1024 + 128); \
        k0 = *(const GAS v4u*)(kg + t_ * 1024); k1 = *(const GAS v4u*)(kg + t_ * 1024 + 128); \
        v0 = *(const GAS v4u*)(vg + t_ * 2048); v1 = *(const GAS v4u*)(vg + t_ * 2048 + 128); \
        if (dir == 0 && tid < 128) pp = *(const GAS v4u*)(pg + t_ * 128); } while (0)
#define RET_STORE(bufp) do { LAS char* b_ = (bufp); \
        *(LAS v2u*)(b_ + L_Q + qrow * QPITCH + qch * 16) = (v2u){q0.x, q0.y}; *(LAS v2u*)(b_ + L_Q + qrow * QPITCH + qch * 16 + 8) = (v2u){q0.z, q0.w}; \
        *(LAS v2u*)(b_ + L_Q + qrow * QPITCH + qch * 16 + 256) = (v2u){q1.x, q1.y}; *(LAS v2u*)(b_ + L_Q + qrow * QPITCH + qch * 16 + 264) = (v2u){q1.z, q1.w}; \
        *(LAS v4u*)(b_ + L_KT + wid * 1024 + lane * 16) = k0; *(LAS v4u*)(b_ + L_KT + (wid + 8) * 1024 + lane * 16) = k1; \
        *(LAS v4u*)(b_ + L_VT + wid * 1024 + lane * 16) = v0; *(LAS v4u*)(b_ + L_VT + (wid + 8) * 1024 + lane * 16) = v1; \
        if (dir == 0 && tid < 128) { *(LAS v2u*)(b_ + L_PT + (tid >> 2) * PPITCH + (tid & 3) * 16) = (v2u){pp.x, pp.y}; *(LAS v2u*)(b_ + L_PT + (tid >> 2) * PPITCH + (tid & 3) * 16 + 8) = (v2u){pp.z, pp.w}; } } while (0)
    RET_LOAD(dir == 0 ? 0 : 127);
    RET_STORE(shm);
    __syncthreads();
    const int tro = ((lane >> 4) & 1) * 32 + (lane & 3) * 8 + (4 * hi + ((lane & 15) >> 2)) * 64;
#pragma unroll 1
    for (int s = 0; s < 128; ++s) {
        const int sc = dir == 0 ? s : 127 - s;
        LAS char* buf = shm + (s & 1) * BUFB;
        if (s + 1 < 128) RET_LOAD(dir == 0 ? s + 1 : 126 - s);
        f32x16 out;
#pragma unroll
        for (int r = 0; r < 16; ++r) out[r] = 0.f;
        const LAS char* qb = buf + L_Q + r32 * QPITCH + 8 * hi;
#pragma unroll
        for (int db = 0; db < 8; ++db)
#pragma unroll
            for (int s2 = 0; s2 < 2; ++s2) {
                const bf16x8 sb = pack8(S[db], s2);
                const bf16x8 a = cat8(*(const LAS s16x4*)(qb + (32 * db + 16 * s2) * 2), *(const LAS s16x4*)(qb + (32 * db + 16 * s2) * 2 + 16));
                out = __builtin_amdgcn_mfma_f32_32x32x16_bf16(a, sb, out, 0, 0, 0);
            }
        { float f8 = xiB;
#pragma unroll
          for (int g4 = 0; g4 < 4; ++g4) { float fz = f8;
#pragma unroll
              for (int z = 0; z < 4; ++z) { out[4 * g4 + z] *= fz; fz *= xiU; }
              f8 *= xiW; } }
        bf16x8 vf[2];
#pragma unroll
        for (int ks = 0; ks < 2; ++ks) vf[ks] = cat8(vtr(buf + L_VT + wid * 2048 + ks * 1024 + tro), vtr(buf + L_VT + wid * 2048 + ks * 1024 + 512 + tro));
        if (dir == 0) {
            const LAS char* pb = buf + L_PT + r32 * PPITCH + 8 * hi;
#pragma unroll
            for (int ks = 0; ks < 2; ++ks) {
                const bf16x8 a = cat8(*(const LAS s16x4*)(pb + 32 * ks), *(const LAS s16x4*)(pb + 32 * ks + 16));
                out = __builtin_amdgcn_mfma_f32_32x32x16_bf16(a, vf[ks], out, 0, 0, 0);
            }
        }
        { const int odd = lane & 1;
          bf16* op = A.OUT + ((size_t)b * SEQ + (size_t)sc * 32) * 2048 + h * 512 + vs * 256 + 32 * wid + (r32 & ~1) + (size_t)(odd + 4 * hi) * 2048;
#pragma unroll
          for (int t = 0; t < 8; ++t) { const float xe = out[2 * t], xo = out[2 * t + 1];
              const float send = odd ? xe : xo;
              const float recv = __uint_as_float((unsigned)__builtin_amdgcn_mov_dpp((int)__float_as_uint(send), 0xB1, 0xF, 0xF, true));
              const unsigned w = odd ? cvtpk(recv, xo) : cvtpk(xe, recv);
              *(GAS unsigned*)(op + (size_t)(((2 * t) & 3) + 8 * (t >> 1)) * 2048) = w; } }
#pragma unroll
        for (int db = 0; db < 8; ++db) {
#pragma unroll
            for (int r = 0; r < 16; ++r) S[db][r] *= decay;
#pragma unroll
            for (int ks = 0; ks < 2; ++ks) {
                const bf16x8 a = cat8(vtr(buf + L_KT + db * 2048 + ks * 1024 + tro), vtr(buf + L_KT + db * 2048 + ks * 1024 + 512 + tro));
                S[db] = __builtin_amdgcn_mfma_f32_32x32x16_bf16(a, vf[ks], S[db], 0, 0, 0);
            }
        }
        if (s + 1 < 128) RET_STORE(shm + ((s + 1) & 1) * BUFB);
        __syncthreads();
    }
#undef RET_LOAD
#undef RET_STORE
}
}

struct Args {
    const float* x; const float* diff_norm; const float* diff_w_in; const float* diff_w_out;
    const float* lq1; const float* lk1; const float* lq2; const float* lk2; const float* qn; const float* kn; const float* subln;
    const float* ret_norm; const float* ret_w_in; const float* ret_w_out; const float* lgf; const float* lgb;
    const float* moe_norm; const float* moe_rw; const float* moe_rb; const float* moe_w1; const float* moe_b1; const float* moe_w2; const float* moe_b2;
    float* out; unsigned char* ws; int ph_lo, ph_hi;
};
struct Frame {
    LAS unsigned char* lds; LAS int* misc;
    int tid, lane, wave, vcu, G;
};
constexpr int MI_TOFF = 16, MI_LCNT = 80, MI_LBASE = 112, MI_WSCR = 256, MI_STR = 768, MI_STEP = 1024, MI_STG = 2048;

__device__ __forceinline__ void load_row(const float* xrow, int lane, f32x4 (&v)[4]) {
    const GAS f32x4* p = (const GAS f32x4*)xrow + lane;
#pragma unroll
    for (int j = 0; j < 4; ++j) v[j] = p[64 * j];
}
__device__ __forceinline__ void rms_row(const f32x4 (&v)[4], const f32x4 (&g)[4], f32x4 (&h)[4]) {
    float s = 0.f;
#pragma unroll
    for (int j = 0; j < 4; ++j) s += (v[j][0] * v[j][0] + v[j][1] * v[j][1]) + (v[j][2] * v[j][2] + v[j][3] * v[j][3]);
    const float rstd = 1.0f / sqrtf(wave_sum(s) * (1.0f / DM) + NORM_EPS);
#pragma unroll
    for (int j = 0; j < 4; ++j) h[j] = v[j] * rstd * g[j];
}
__device__ __forceinline__ void store_row_bf16(bf16* hrow, int lane, const f32x4 (&h)[4]) {
    GAS v2u* o = (GAS v2u*)hrow + lane;
#pragma unroll
    for (int j = 0; j < 4; ++j) { v2u w; w.x = cvtpk(h[j][0], h[j][1]); w.y = cvtpk(h[j][2], h[j][3]); o[64 * j] = w; }
}

__device__ __forceinline__ void transpose_item(const float* W, int K, int N, bf16* WT, LAS float* scr, int item, int lane) {
    const int nblk = N / 32, kb = item / nblk, nb = item % nblk, k0 = 64 * kb, n0 = 32 * nb;
#pragma unroll 8
    for (int i = 0; i < 32; ++i) { const int kk = 2 * i + (lane >> 5); scr[kk * 33 + (lane & 31)] = ((const GAS float*)W)[(size_t)(k0 + kk) * N + n0 + (lane & 31)]; }
    asm volatile("s_waitcnt lgkmcnt(0)" ::: "memory");
    const int c = lane & 7;
#pragma unroll
    for (int j = 0; j < 4; ++j) { const int n = (lane >> 3) + 8 * j; const LAS float* s = scr + (8 * c) * 33 + n;
        v4u o; o.x = cvtpk(s[0 * 33], s[1 * 33]); o.y = cvtpk(s[2 * 33], s[3 * 33]); o.z = cvtpk(s[4 * 33], s[5 * 33]); o.w = cvtpk(s[6 * 33], s[7 * 33]);
        *(GAS v4u*)(WT + (size_t)(n0 + n) * K + k0 + 8 * c) = o; }
    asm volatile("s_waitcnt lgkmcnt(0)" ::: "memory");
}
#ifndef QKV_FP8
#define QKV_FP8 0
#endif
#ifndef DO_FP8
#define DO_FP8 1
#endif
#ifndef RO_FP8
#define RO_FP8 1
#endif
#ifndef RET_FP8
#define RET_FP8 1
#endif
__device__ __forceinline__ void transpose_item_fp8(const float* W, int K, int N, unsigned char* WT, float scale, LAS float* scr, int item, int lane) {
    const int nblk = N / 32, kb = item / nblk, nb = item % nblk, k0 = 64 * kb, n0 = 32 * nb;
#pragma unroll 8
    for (int i = 0; i < 32; ++i) { const int kk = 2 * i + (lane >> 5); scr[kk * 33 + (lane & 31)] = ((const GAS float*)W)[(size_t)(k0 + kk) * N + n0 + (lane & 31)]; }
    asm volatile("s_waitcnt lgkmcnt(0)" ::: "memory");
    const int n = lane >> 1, kh = lane & 1; const LAS float* s = scr + (32 * kh) * 33 + n;
    v4u o[2];
#pragma unroll
    for (int q = 0; q < 2; ++q) { unsigned w[4];
#pragma unroll
        for (int z = 0; z < 4; ++z) { const LAS float* t = s + (16 * q + 4 * z) * 33; w[z] = pg8::pack_fp8x4(t[0] * scale, t[33] * scale, t[66] * scale, t[99] * scale); }
        o[q] = (v4u){w[0], w[1], w[2], w[3]}; }
    unsigned char* dst = WT + (size_t)(n0 + n) * K + k0 + 32 * kh;
    *(GAS v4u*)dst = o[0]; *(GAS v4u*)(dst + 16) = o[1];
    asm volatile("s_waitcnt lgkmcnt(0)" ::: "memory");
}
__device__ __forceinline__ Frame relaunder(const Frame& F0) { Frame F = F0; F.tid = opaque_tid(); F.lane = F.tid & 63; F.wave = __builtin_amdgcn_readfirstlane(F.tid >> 6); return F; }
struct ConvItem { const float* W; unsigned char* WT; int K, N, k0, n0; float scale; };
__device__ __forceinline__ ConvItem conv_decode(const Args& a, int r) {
    constexpr int I2 = 2 * 16 * 192, I3 = 2 * 32 * 32, I4 = 128 * 16 * 64;
    ConvItem c; int per, nblk;
    if (r < I2) { per = 16 * 192; const int mi = r / per; c.W = a.ret_w_in + (size_t)mi * 1024 * 6144; c.WT = a.ws + WS_WRI + (size_t)mi * 6144 * 1024; c.K = 1024; c.N = 6144; c.scale = WRI_SCALE; r -= mi * per; }
    else if ((r -= I2) < I3) { per = 32 * 32; const int mi = r / per; c.W = a.ret_w_out + (size_t)mi * 2048 * 1024; c.WT = a.ws + WS_WRO + (size_t)mi * 1024 * 2048; c.K = 2048; c.N = 1024; c.scale = WRO_SCALE; r -= mi * per; }
    else if ((r -= I3) < I4) { per = 16 * 64; const int mi = r / per; c.W = a.moe_w1 + (size_t)mi * 1024 * 2048; c.WT = a.ws + WS_W1 + (size_t)mi * 2048 * 1024; c.K = 1024; c.N = 2048; c.scale = W1_SCALE; r -= mi * per; }
    else { r -= I4; per = 16 * 32; const int mi = r / per; c.W = a.moe_w2 + (size_t)mi * 1024 * 1024; c.WT = a.ws + WS_W2 + (size_t)mi * 1024 * 1024; c.K = 1024; c.N = 1024; c.scale = W2_SCALE; r -= mi * per; }
    nblk = c.N / 32; c.k0 = 64 * (r / nblk); c.n0 = 32 * (r % nblk); return c;
}
__device__ __forceinline__ void conv_load(const ConvItem& c, int lane, f32x4 (&v)[8]) {
    const GAS float* p = (const GAS float*)c.W + (size_t)(c.k0 + 8 * (lane >> 3)) * c.N + c.n0 + 4 * (lane & 7);
#pragma unroll
    for (int i = 0; i < 8; ++i) v[i] = __builtin_nontemporal_load((const GAS f32x4*)(p + (size_t)i * c.N));
}
__device__ __forceinline__ void conv_finish(const ConvItem& c, int lane, const f32x4 (&v)[8]) {
    unsigned char* dst = c.WT + (size_t)(c.n0 + 4 * (lane & 7)) * c.K + c.k0 + 8 * (lane >> 3);
#pragma unroll
    for (int z = 0; z < 4; ++z) { v2u w;
        w.x = pg8::pack_fp8x4(v[0][z] * c.scale, v[1][z] * c.scale, v[2][z] * c.scale, v[3][z] * c.scale);
        w.y = pg8::pack_fp8x4(v[4][z] * c.scale, v[5][z] * c.scale, v[6][z] * c.scale, v[7][z] * c.scale);
        *(GAS v2u*)(dst + (size_t)z * c.K) = w; }
}
__device__ __forceinline__ void deferred_conversion(const Frame& F0, const Args& a) {
    const Frame F = relaunder(F0);
    const int gw = F.vcu * 8 + F.wave, NGW = F.G * 8;
    constexpr int NDEF = 2 * 16 * 192 + 2 * 32 * 32 + 128 * 16 * 64 + 128 * 16 * 32;
    if (gw >= NDEF) return;
    const int n = (NDEF - gw + NGW - 1) / NGW;
    f32x4 va[8], vb[8], vc[8], vd[8];
#define CV_ITEM(j_) conv_decode(a, gw + ((j_) < n ? (j_) : n - 1) * NGW)
    conv_load(CV_ITEM(0), F.lane, va); conv_load(CV_ITEM(1), F.lane, vb); conv_load(CV_ITEM(2), F.lane, vc); conv_load(CV_ITEM(3), F.lane, vd);
#pragma unroll 1
    for (int j = 0; j < n; j += 4) {
        conv_finish(CV_ITEM(j), F.lane, va); conv_load(CV_ITEM(j + 4), F.lane, va);
        conv_finish(CV_ITEM(j + 1), F.lane, vb); conv_load(CV_ITEM(j + 5), F.lane, vb);
        conv_finish(CV_ITEM(j + 2), F.lane, vc); conv_load(CV_ITEM(j + 6), F.lane, vc);
        conv_finish(CV_ITEM(j + 3), F.lane, vd); conv_load(CV_ITEM(j + 7), F.lane, vd);
    }
#undef CV_ITEM
}
#ifndef DEFER_CONV
#define DEFER_CONV (RET_FP8 && RO_FP8)
#endif
__device__ __forceinline__ void prologue_phase(const Frame& F0, const Args& a) {
    const Frame F = relaunder(F0);
    LAS float* scr = (LAS float*)(F.lds + F.wave * 16384);
    const int gw = F.vcu * 8 + F.wave, NGW = F.G * 8;
    constexpr int I0 = 2 * 16 * 96, I1 = 2 * 16 * 32, I2 = 2 * 16 * 192, I3 = 2 * 32 * 32, I4 = 128 * 16 * 64, I5 = 128 * 16 * 32;
    constexpr int NITEMS = I0 + I1 + I2 + I3 + I4 + I5;
    for (int it = gw; it < (DEFER_CONV ? I0 + I1 : NITEMS); it += NGW) {
        int r = it;
        if (r < I0) { const int per = 16 * 96, mi = r / per; if (QKV_FP8) transpose_item_fp8(a.diff_w_in + (size_t)mi * 1024 * 3072, 1024, 3072, a.ws + WS_WDI + (size_t)mi * 3072 * 1024, WRI_SCALE, scr, r % per, F.lane); else transpose_item(a.diff_w_in + (size_t)mi * 1024 * 3072, 1024, 3072, (bf16*)(a.ws + WS_WDI) + (size_t)mi * 3072 * 1024, scr, r % per, F.lane); continue; } r -= I0;
        if (r < I1) { const int per = 16 * 32, mi = r / per; if (DO_FP8) transpose_item_fp8(a.diff_w_out + (size_t)mi * 1024 * 1024, 1024, 1024, a.ws + WS_WDO + (size_t)mi * 1024 * 1024, WDO_SCALE, scr, r % per, F.lane); else transpose_item(a.diff_w_out + (size_t)mi * 1024 * 1024, 1024, 1024, (bf16*)(a.ws + WS_WDO) + (size_t)mi * 1024 * 1024, scr, r % per, F.lane); continue; } r -= I1;
        if (r < I2) { const int per = 16 * 192, mi = r / per; if (RET_FP8) transpose_item_fp8(a.ret_w_in + (size_t)mi * 1024 * 6144, 1024, 6144, a.ws + WS_WRI + (size_t)mi * 6144 * 1024, WRI_SCALE, scr, r % per, F.lane);
            else transpose_item(a.ret_w_in + (size_t)mi * 1024 * 6144, 1024, 6144, (bf16*)(a.ws + WS_WRI) + (size_t)mi * 6144 * 1024, scr, r % per, F.lane); continue; } r -= I2;
        if (r < I3) { const int per = 32 * 32, mi = r / per; if (RO_FP8) transpose_item_fp8(a.ret_w_out + (size_t)mi * 2048 * 1024, 2048, 1024, a.ws + WS_WRO + (size_t)mi * 1024 * 2048, WRO_SCALE, scr, r % per, F.lane); else transpose_item(a.ret_w_out + (size_t)mi * 2048 * 1024, 2048, 1024, (bf16*)(a.ws + WS_WRO) + (size_t)mi * 1024 * 2048, scr, r % per, F.lane); continue; } r -= I3;
        if (r < I4) { const int per = 16 * 64, mi = r / per; transpose_item_fp8(a.moe_w1 + (size_t)mi * 1024 * 2048, 1024, 2048, a.ws + WS_W1 + (size_t)mi * 2048 * 1024, W1_SCALE, scr, r % per, F.lane); continue; } r -= I4;
        { const int per = 16 * 32, mi = r / per; transpose_item_fp8(a.moe_w2 + (size_t)mi * 1024 * 1024, 1024, 1024, a.ws + WS_W2 + (size_t)mi * 1024 * 1024, W2_SCALE, scr, r % per, F.lane); }
    }
    { bf16* wg = (bf16*)(a.ws + WS_WRT);
      for (int idx = gw * 64 + F.lane; idx < DEPTH * DM * NEXP; idx += NGW * 64) { const int l = idx >> 15, r = idx & 32767, e = r & 31, k = r >> 5;
          const float w = ((const GAS float*)a.moe_rw)[idx] * ((const GAS float*)a.moe_norm)[l * DM + k];
          const unsigned hi = cvtpk(w, 0.f) & 0xffffu; const unsigned lo = cvtpk(w - __uint_as_float(hi << 16), 0.f) & 0xffffu;
          ((GAS bf16*)wg)[(size_t)l * (2 * NEXP * WRP) + e * WRP + k] = (bf16)hi; ((GAS bf16*)wg)[(size_t)l * (2 * NEXP * WRP) + NEXP * WRP + e * WRP + k] = (bf16)lo; } }
    f32x4 g[4]; load_row(a.diff_norm, F.lane, g);
    bf16* HB = (bf16*)(a.ws + WS_HB);
    for (int m = gw; m < NTOK; m += NGW) { f32x4 v[4], h[4]; load_row(a.x + (size_t)m * DM, F.lane, v); rms_row(v, g, h);
        if (QKV_FP8) { GAS unsigned* o8 = (GAS unsigned*)(a.ws + WS_HB8 + (size_t)m * DM) + F.lane;
#pragma unroll
            for (int j = 0; j < 4; ++j) o8[64 * j] = pg8::pack_fp8x4(h[j][0] * H8_SCALE, h[j][1] * H8_SCALE, h[j][2] * H8_SCALE, h[j][3] * H8_SCALE); }
        else store_row_bf16(HB + (size_t)m * DM, F.lane, h);
        store_row_bf16((bf16*)(a.ws + WS_XB) + (size_t)m * DM, F.lane, v); }
}

__device__ __forceinline__ void compute_toff(const Frame& F, const int* cnt) {
    if (opaque_tid() == 0) { int acc = 0;
        for (int e = 0; e < NEXP; ++e) { const int c_ = ((const GAS int*)cnt)[e]; F.misc[MI_TOFF + e] = acc; F.misc[MI_TOFF + 128 + e] = c_; acc += (c_ + 255) >> 8; }
        F.misc[MI_TOFF + 32] = acc; }
    __syncthreads();
    { LAS unsigned char* texp = (LAS unsigned char*)F.misc + 4 * MI_STG; const int TM = F.misc[MI_TOFF + 32];
      for (int t = opaque_tid(); t < TM; t += 512) { int e = 0;
#pragma unroll
          for (int k = 1; k < 32; ++k) e += (F.misc[MI_TOFF + k] <= t) ? 1 : 0;
          texp[t] = (unsigned char)e; } }
    __syncthreads();
}

__device__ __forceinline__ void tb_phase(const Frame& F0, const Args& a, int layer) {
    const Frame F = relaunder(F0);
    const float* rb = a.moe_rb + layer * NEXP;
    int* gcnt = (int*)(a.ws + WS_CTL) + CW_CNT + layer * NEXP;
    int* list = (int*)(a.ws + WS_LIST); int* tslot = (int*)(a.ws + WS_TSLOT); float* tgate = (float*)(a.ws + WS_TGATE); float* lrs = (float*)(a.ws + WS_LRS);
    unsigned char* HB8 = a.ws + WS_HB8;
    LAS bf16* WrT = (LAS bf16*)F.lds;
    { const GAS v4u* src = (const GAS v4u*)((const bf16*)(a.ws + WS_WRT) + (size_t)layer * (2 * NEXP * WRP));
      constexpr int NV = 2 * NEXP * WRP / 8, NFULL = NV / 512;
      v4u t_[NFULL];
#pragma unroll
      for (int i = 0; i < NFULL; ++i) t_[i] = src[F.tid + 512 * i];
      v4u tail_ = {0u, 0u, 0u, 0u}; if (F.tid < NV - 512 * NFULL) tail_ = src[512 * NFULL + F.tid];
#pragma unroll
      for (int i = 0; i < NFULL; ++i) ((LAS v4u*)WrT)[F.tid + 512 * i] = t_[i];
      if (F.tid < NV - 512 * NFULL) ((LAS v4u*)WrT)[512 * NFULL + F.tid] = tail_; }
    LAS int* lcnt = F.misc + MI_LCNT; LAS int* lbase = F.misc + MI_LBASE;
    LAS float* scr = (LAS float*)(F.lds + (F.wave < 6 ? 2 * NEXP * WRP * 2 + 2048 * F.wave : MISC_OFF + 12288 + 2048 * (F.wave - 6)));
    LAS unsigned* st_ep = (LAS unsigned*)(F.misc + MI_STEP); LAS float* st_g = (LAS float*)(F.misc + MI_STG); LAS float* st_r = (LAS float*)(F.misc + MI_STR);
    const int e_me = F.lane & 31, hsel = F.lane >> 5, r16 = F.lane & 15, kq = F.lane >> 4;
    const float bv0 = ((const GAS float*)rb)[r16], bv1 = ((const GAS float*)rb)[16 + r16];
    for (int bt = F.vcu; bt < NTOK / 256; bt += F.G) {
        if (F.tid < 32) lcnt[F.tid] = 0;
        __syncthreads();
#pragma unroll 1
        for (int gi = 0; gi < 2; ++gi) {
            const int rl0 = F.wave * 32 + 16 * gi; const size_t row = (size_t)bt * 256 + rl0 + r16;
            const GAS v4u* dp = (const GAS v4u*)(a.ws + WS_XB + (row * DM + 16 * kq) * 2);
            GAS v4u* op = (GAS v4u*)(HB8 + row * DM + 16 * kq);
            const LAS bf16* wp = WrT + r16 * WRP + 16 * kq;
            const GAS f32x4* gp = (const GAS f32x4*)(a.moe_norm + (size_t)layer * DM + 16 * kq);
            f32x4 acc0 = {0.f, 0.f, 0.f, 0.f}, acc1 = {0.f, 0.f, 0.f, 0.f}; float ss = 0.f;
            v4u da[2], db[2];
            da[0] = dp[0]; da[1] = dp[1]; db[0] = dp[8]; db[1] = dp[9];
#define TB_STEP(dc, T_) do { const int T = (T_); f32x4 v[4]; \
                v[0] = (f32x4){bflo(dc[0].x), bfhi(dc[0].x), bflo(dc[0].y), bfhi(dc[0].y)}; \
                v[1] = (f32x4){bflo(dc[0].z), bfhi(dc[0].z), bflo(dc[0].w), bfhi(dc[0].w)}; \
                v[2] = (f32x4){bflo(dc[1].x), bfhi(dc[1].x), bflo(dc[1].y), bfhi(dc[1].y)}; \
                v[3] = (f32x4){bflo(dc[1].z), bfhi(dc[1].z), bflo(dc[1].w), bfhi(dc[1].w)}; \
                _Pragma("unroll") for (int z = 0; z < 4; ++z) ss += (v[z][0] * v[z][0] + v[z][1] * v[z][1]) + (v[z][2] * v[z][2] + v[z][3] * v[z][3]); \
                _Pragma("unroll") for (int z = 0; z < 4; ++z) v[z] = v[z] * gp[16 * T + z]; \
                const bf16x8 a0 = __builtin_bit_cast(bf16x8, dc[0]), a1 = __builtin_bit_cast(bf16x8, dc[1]);     \
                { const int Tn = T + 2 < 16 ? T + 2 : T; \
                  dc[0] = dp[8 * Tn]; dc[1] = dp[8 * Tn + 1]; } \
                v4u o; \
                o.x = pg8::pack_fp8x4(v[0][0] * H8U_SCALE, v[0][1] * H8U_SCALE, v[0][2] * H8U_SCALE, v[0][3] * H8U_SCALE); \
                o.y = pg8::pack_fp8x4(v[1][0] * H8U_SCALE, v[1][1] * H8U_SCALE, v[1][2] * H8U_SCALE, v[1][3] * H8U_SCALE); \
                o.z = pg8::pack_fp8x4(v[2][0] * H8U_SCALE, v[2][1] * H8U_SCALE, v[2][2] * H8U_SCALE, v[2][3] * H8U_SCALE); \
                o.w = pg8::pack_fp8x4(v[3][0] * H8U_SCALE, v[3][1] * H8U_SCALE, v[3][2] * H8U_SCALE, v[3][3] * H8U_SCALE); \
                op[4 * T] = o; \
                _Pragma("unroll") for (int s_ = 0; s_ < 2; ++s_) { const bf16x8 av = s_ ? a1 : a0; const LAS bf16* w_ = wp + 64 * T + 8 * s_; \
                    acc0 = __builtin_amdgcn_mfma_f32_16x16x32_bf16(av, *(const LAS bf16x8*)(w_), acc0, 0, 0, 0); \
                    acc1 = __builtin_amdgcn_mfma_f32_16x16x32_bf16(av, *(const LAS bf16x8*)(w_ + 16 * WRP), acc1, 0, 0, 0); \
                    acc0 = __builtin_amdgcn_mfma_f32_16x16x32_bf16(av, *(const LAS bf16x8*)(w_ + NEXP * WRP), acc0, 0, 0, 0); \
                    acc1 = __builtin_amdgcn_mfma_f32_16x16x32_bf16(av, *(const LAS bf16x8*)(w_ + NEXP * WRP + 16 * WRP), acc1, 0, 0, 0); } } while (0)
#pragma unroll 1
            for (int T2 = 0; T2 < 8; ++T2) { TB_STEP(da, 2 * T2); TB_STEP(db, 2 * T2 + 1); }
#undef TB_STEP
            { const int l_ = lane_now(); ss += shfl_xor_(ss, 16, l_); ss += shfl_xor_(ss, 32, l_); }
            const float rstd = 1.0f / sqrtf(ss * (1.0f / DM) + NORM_EPS);
            if (F.lane < 16) st_r[rl0 + F.lane] = rstd;
#pragma unroll
            for (int i = 0; i < 4; ++i) { const float ri = shfl_idx_(rstd, 4 * kq + i);
                scr[(4 * kq + i) * 32 + r16] = acc0[i] * ri + bv0; scr[(4 * kq + i) * 32 + 16 + r16] = acc1[i] * ri + bv1; }
            asm volatile("s_waitcnt lgkmcnt(0)" ::: "memory");
#pragma unroll 1
            for (int it = 0; it < 8; ++it) {
                const int rowl = rl0 + 2 * it;
                const LAS float* lrow = scr + (2 * it + hsel) * 32;
                const float val = lrow[e_me];
                int rank = 0;
#pragma unroll
                for (int q = 0; q < 8; ++q) { const f32x4 t = *(const LAS f32x4*)(lrow + 4 * q);
#pragma unroll
                    for (int z = 0; z < 4; ++z) { const int ee = 4 * q + z; rank += (t[z] > val || (t[z] == val && ee < e_me)) ? 1 : 0; } }
                float vA[4], vB[4]; int eA[4], eB[4];
#pragma unroll
                for (int k = 0; k < 4; ++k) { const unsigned long long mk = __ballot(rank == k);
                    const int la = __builtin_amdgcn_readfirstlane(__builtin_ctz((unsigned)(mk & 0xffffffffull) | 0x80000000u));
                    const int lb = __builtin_amdgcn_readfirstlane(__builtin_ctz((unsigned)(mk >> 32) | 0x80000000u));
                    eA[k] = la; eB[k] = lb;
                    vA[k] = __uint_as_float(__builtin_amdgcn_readlane(__float_as_uint(val), la)); vB[k] = __uint_as_float(__builtin_amdgcn_readlane(__float_as_uint(val), 32 + lb)); }
                float gA[4], gB[4]; float sA = 0.f, sB = 0.f;
#pragma unroll
                for (int k = 0; k < 4; ++k) { gA[k] = __expf(vA[k] - vA[0]); gB[k] = __expf(vB[k] - vB[0]); sA += gA[k]; sB += gB[k]; }
                if (F.lane < 8) { const int r = F.lane >> 2, k = F.lane & 3;
                    const int e0 = r ? eB[0] : eA[0], e1 = r ? eB[1] : eA[1], e2 = r ? eB[2] : eA[2], e3 = r ? eB[3] : eA[3];
                    const float g0 = r ? gB[0] : gA[0], g1 = r ? gB[1] : gA[1], g2 = r ? gB[2] : gA[2], g3 = r ? gB[3] : gA[3];
                    const int e_ = k == 0 ? e0 : (k == 1 ? e1 : (k == 2 ? e2 : e3)); const float g_ = (k == 0 ? g0 : (k == 1 ? g1 : (k == 2 ? g2 : g3))) / (r ? sB : sA);
                    const int pl = atomicAdd((int*)(lcnt + e_), 1);
                    st_ep[(rowl + r) * 4 + k] = (unsigned)e_ | ((unsigned)pl << 8); st_g[(rowl + r) * 4 + k] = g_; }
            }
        }
        __syncthreads();
        if (F.tid < 32) lbase[F.tid] = atomicAdd(gcnt + F.tid, lcnt[F.tid]);
        __syncthreads();
        for (int idx = F.tid; idx < 1024; idx += 512) { const int rowl = idx >> 2, k = idx & 3; const unsigned ep = st_ep[idx]; const int e = (int)(ep & 255u); const int pos = lbase[e] + (int)(ep >> 8);
            const int tok = bt * 256 + rowl; ((GAS int*)list)[(size_t)e * NTOK + pos] = tok; ((GAS float*)lrs)[(size_t)e * NTOK + pos] = st_r[rowl]; ((GAS int*)tslot)[tok * 4 + k] = (e << 20) | pos; ((GAS float*)tgate)[tok * 4 + k] = st_g[idx]; }
        __syncthreads();
    }
}

__device__ __forceinline__ void tc_phase(const Frame& F0, const Args& a, bool last  , const float* gain  , bool h8, bool dry = false) {
    const Frame F = relaunder(F0);
    const int* tslot = (const int*)(a.ws + WS_TSLOT); const float* tgate = (const float*)(a.ws + WS_TGATE);
    const bf16* Y = (const bf16*)(a.ws + WS_Y); bf16* HB = (bf16*)(a.ws + WS_HB);
    f32x4 g[4];
    if (gain) load_row(gain, F.lane, g);
    const int gw = F.vcu * 8 + F.wave, NGW = F.G * 8;
    for (int m = gw; m < NTOK; m += NGW) {
        f32x4 v[4];
        { const GAS v2u* dr = (const GAS v2u*)(a.ws + WS_XB + (size_t)m * DM * 2) + F.lane;
#pragma unroll
          for (int j = 0; j < 4; ++j) { const v2u w = dr[64 * j]; v[j][0] = bflo(w.x); v[j][1] = bfhi(w.x); v[j][2] = bflo(w.y); v[j][3] = bfhi(w.y); } }
#pragma unroll
        for (int k = 0; k < 4; ++k) { const int ts = ((const GAS int*)tslot)[m * 4 + k]; const float gt = ((const GAS float*)tgate)[m * 4 + k]; const int e = ts >> 20, pos = ts & 0xfffff;
            const size_t slot = (size_t)F.misc[MI_TOFF + e] * 256 + pos;
            if (Y_FP8) { const GAS int* yr = (const GAS int*)((const unsigned char*)Y + slot * DM) + F.lane; const float g8 = gt * (1.0f / Y8_SCALE);
#pragma unroll
                for (int j = 0; j < 4; ++j) { const int w = yr[64 * j]; const f32x2 lo = __builtin_amdgcn_cvt_pk_f32_fp8(w, false), hi = __builtin_amdgcn_cvt_pk_f32_fp8(w, true);
                    v[j][0] += g8 * lo.x; v[j][1] += g8 * lo.y; v[j][2] += g8 * hi.x; v[j][3] += g8 * hi.y; } }
            else { const GAS v2u* yr = (const GAS v2u*)(Y + slot * DM) + F.lane;
#pragma unroll
                for (int j = 0; j < 4; ++j) { const v2u w = yr[64 * j]; v[j][0] += gt * bflo(w.x); v[j][1] += gt * bfhi(w.x); v[j][2] += gt * bflo(w.y); v[j][3] += gt * bfhi(w.y); } } }
        if (!dry) {
            if (last) { GAS f32x4* o = (GAS f32x4*)(a.out + (size_t)m * DM) + F.lane;
#pragma unroll
                for (int j = 0; j < 4; ++j) o[64 * j] = v[j]; }
            else store_row_bf16((bf16*)(a.ws + WS_XB) + (size_t)m * DM, F.lane, v); }
        if (gain) { f32x4 h[4]; rms_row(v, g, h);
            if (h8) { GAS unsigned* o8 = (GAS unsigned*)(a.ws + WS_HB8 + (size_t)m * DM) + F.lane;
#pragma unroll
                for (int j = 0; j < 4; ++j) o8[64 * j] = pg8::pack_fp8x4(h[j][0] * H8_SCALE, h[j][1] * H8_SCALE, h[j][2] * H8_SCALE, h[j][3] * H8_SCALE); }
            else store_row_bf16(HB + (size_t)m * DM, F.lane, h); }
    }
}

__device__ __forceinline__ void td_phase(const Frame& F0, const Args& a) {
    const Frame F = relaunder(F0);
    const bf16* OF = (const bf16*)(a.ws + WS_ROF); const bf16* OB = (const bf16*)(a.ws + WS_ROB); const bf16* RG = (const bf16*)(a.ws + WS_PROJ + 640 * MiB); bf16* GO = (bf16*)(a.ws + WS_RGO);
    const int gw = F.vcu * 8 + F.wave, NGW = F.G * 8;
    for (int m = gw; m < NTOK; m += NGW) {
#pragma unroll
        for (int hd = 0; hd < 4; ++hd) { const size_t off = (size_t)m * 2048 + hd * 512 + 8 * F.lane;
            const v4u f = *(const GAS v4u*)(OF + off), b = *(const GAS v4u*)(OB + off), gg = *(const GAS v4u*)(RG + off);
            float o[8]; o[0] = bflo(f.x) + bflo(b.x); o[1] = bfhi(f.x) + bfhi(b.x); o[2] = bflo(f.y) + bflo(b.y); o[3] = bfhi(f.y) + bfhi(b.y);
            o[4] = bflo(f.z) + bflo(b.z); o[5] = bfhi(f.z) + bfhi(b.z); o[6] = bflo(f.w) + bflo(b.w); o[7] = bfhi(f.w) + bfhi(b.w);
            float s = 0.f;
#pragma unroll
            for (int i = 0; i < 8; ++i) s += o[i] * o[i];
            const float rstd = 1.0f / sqrtf(wave_sum(s) * (1.0f / 512.0f) + NORM_EPS);
            float gv[8]; gv[0] = bflo(gg.x); gv[1] = bfhi(gg.x); gv[2] = bflo(gg.y); gv[3] = bfhi(gg.y); gv[4] = bflo(gg.z); gv[5] = bfhi(gg.z); gv[6] = bflo(gg.w); gv[7] = bfhi(gg.w);
#pragma unroll
            for (int i = 0; i < 8; ++i) { const float sg = gv[i] * __builtin_amdgcn_rcpf(1.0f + __builtin_amdgcn_exp2f(-LOG2E * gv[i])); o[i] = o[i] * rstd * sg; }
            if (RO_FP8) { v2u w; w.x = pg8::pack_fp8x4(o[0] * GO8_SCALE, o[1] * GO8_SCALE, o[2] * GO8_SCALE, o[3] * GO8_SCALE); w.y = pg8::pack_fp8x4(o[4] * GO8_SCALE, o[5] * GO8_SCALE, o[6] * GO8_SCALE, o[7] * GO8_SCALE);
                *(GAS v2u*)((unsigned char*)GO + off) = w; }
            else { v4u w; w.x = cvtpk(o[0], o[1]); w.y = cvtpk(o[2], o[3]); w.z = cvtpk(o[4], o[5]); w.w = cvtpk(o[6], o[7]);
                *(GAS v4u*)(GO + off) = w; } }
    }
}

constexpr int N_PHASES = 1 + 9 * DEPTH;
#ifndef MOE_ALIGN
#define MOE_ALIGN true
#endif
__global__ void __launch_bounds__(512, 2) fwd_kernel(Args a) {
    static_assert(WTAB_BYTES == MISC_OFF + 4 * 192, "wave table location");
    static_assert(pg8::TEXP_REL == 4 * MI_STG - 4 * MI_TOFF && pg8::PARK_OFF == MISC_OFF + 12288 && pg8::LISTPARK_OFF == MISC_OFF + 4 * MI_STEP, "park buffers");
    Frame F;
    F.lds = (LAS unsigned char*)lds_raw; F.misc = (LAS int*)(F.lds + MISC_OFF);
    F.tid = threadIdx.x; F.lane = F.tid & 63; F.wave = __builtin_amdgcn_readfirstlane(F.tid >> 6);
    F.G = gridDim.x; { const int bx = blockIdx.x; F.vcu = (F.G % 8 == 0) ? (bx % 8) * (F.G / 8) + bx / 8 : bx; }
    for (int u = F.tid; u < (LDS_BYTES - MISC_OFF) / 4; u += 512) F.misc[u] = 0;
    __syncthreads();
    if (F.lane == 0) F.misc[192 + hw_wave_slot()] = F.wave;
    __syncthreads();
    unsigned* barw = (unsigned*)(a.ws + WS_CTL) + CW_BAR;
    const int lo = a.ph_lo, hi = a.ph_hi;
    XcdBarrier bar; bar.bar = barw; bar.x = 0; bar.st = nullptr;
    if (hi - lo > 1) bar = xcd_barrier_post(barw, (volatile LAS unsigned*)F.misc);
#ifndef PH_MASK
#define PH_MASK 0xffff
#endif
#define PHM(b) ((PH_MASK >> (b)) & 1)
#ifndef REP_MASK
#define REP_MASK 0
#endif
#define REPS(b) ((((REP_MASK) >> (b)) & 1) ? 2 : 1)
#define RUN(k) (lo <= (k) && (k) < hi)
#ifdef BAR_TWICE
#define AFTER(k) do { if ((k) + 1 < hi) { xcd_barrier(bar); xcd_barrier(bar); } } while (0)
#else
#define AFTER(k) do { if ((k) + 1 < hi) xcd_barrier(bar); } while (0)
#endif
    unsigned char* ws = a.ws;
    bf16* HB;
    if (PHM(0) && RUN(0)) { for (int rep_ = 0; rep_ < REPS(0); ++rep_) { if (rep_) xcd_barrier(bar); prologue_phase(F, a); } AFTER(0); }
#pragma unroll 1
    for (int i = 0; i < DEPTH; ++i) {
        const int pb = 1 + 9 * i, jl = i >> 1;
        ws = opaque_ptr(ws); HB = (bf16*)(ws + WS_HB);
        if ((i & 1) == 0) {
            bf16* Qb = (bf16*)(ws + WS_PROJ); bf16* Kb = (bf16*)(ws + WS_PROJ + 128 * MiB); bf16* Vb = (bf16*)(ws + WS_PROJ + 256 * MiB); bf16* AO = (bf16*)(ws + WS_AO);
            if (PHM(1) && RUN(pb + 0)) { for (int rep_ = 0; rep_ < REPS(1); ++rep_) { if (rep_) xcd_barrier(bar);
                pg8::DenseProb<1024, 2, QKV_FP8 != 0> P{QKV_FP8 ? (const void*)(ws + WS_HB8) : (const void*)HB, QKV_FP8 ? (const void*)(ws + WS_WDI + (size_t)jl * 3072 * 1024) : (const void*)((const bf16*)(ws + WS_WDI) + (size_t)jl * 3072 * 1024), NTOK / 256, 12, F.G, F.vcu};
                pg8::EpiQKV E{Qb, Kb, Vb, a.qn + jl * 64, a.kn + jl * 64, QKV_FP8 ? 1.0f / (H8_SCALE * WRI_SCALE) : 1.0f};
                pg8::gemm_phase<pg8::DenseProb<1024, 2, QKV_FP8 != 0>, pg8::EpiQKV, true>(F.lds, P, E);
                } AFTER(pb + 0);
            }
            if (PHM(2) && RUN(pb + 2)) { for (int rep_ = 0; rep_ < REPS(2); ++rep_) { if (rep_) xcd_barrier(bar);
                const int ln_ = lane_now();
                float s1 = ((const GAS float*)a.lq1)[jl * 64 + ln_] * ((const GAS float*)a.lk1)[jl * 64 + ln_], s2 = ((const GAS float*)a.lq2)[jl * 64 + ln_] * ((const GAS float*)a.lk2)[jl * 64 + ln_];
                s1 = wave_sum(s1); s2 = wave_sum(s2);
                const float linit = 0.8f - 0.6f * expf(-0.3f * (float)i);
                float gq = fabsf(((const GAS float*)a.qn)[jl * 64 + ln_]), gk = fabsf(((const GAS float*)a.kn)[jl * 64 + ln_]);
#pragma unroll
                for (int o_ = 1; o_ < 64; o_ <<= 1) { gq = fmaxf(gq, shfl_xor_(gq, o_, ln_)); gk = fmaxf(gk, shfl_xor_(gk, o_, ln_)); }
                const float lam_u = __uint_as_float(__builtin_amdgcn_readfirstlane(__float_as_uint(expf(s1) - expf(s2) + linit)));
                att::AttnArgs A{Qb, Kb, Vb, AO, lam_u, a.subln + jl * 128, 1.0f - linit, 8.1f * gq * gk};
                for (int u = F.vcu; u < NBATCH * 8 * 16; u += F.G) { const int bq = u % (NBATCH * 16), h = u / (NBATCH * 16); att::attn_unit(bq >> 4, h, h == 3 ? ((bq + 8) & 15) : (bq & 15), A, (LAS char*)F.lds);
                    if (DEFER_CONV && i == 0 && rep_ == 0 && h == 2 + (F.vcu % 5)) { deferred_conversion(F, a); } }
#ifdef ATT_TWICE
                xcd_barrier(bar);
                for (int u = F.vcu; u < NBATCH * 8 * 16; u += F.G) { const int bq = u % (NBATCH * 16), h = u / (NBATCH * 16); att::attn_unit(bq >> 4, h, h == 3 ? ((bq + 8) & 15) : (bq & 15), A, (LAS char*)F.lds); }
#endif
                } AFTER(pb + 2);
            }
            if (PHM(3) && RUN(pb + 4)) {
                pg8::DenseProb<1024, 1, DO_FP8 != 0> P{AO, DO_FP8 ? (const void*)(ws + WS_WDO + (size_t)jl * 1024 * 1024) : (const void*)((const bf16*)(ws + WS_WDO) + (size_t)jl * 1024 * 1024), NTOK / 256, 4, F.G, F.vcu};
                pg8::EpiDelta E{(bf16*)(ws + WS_XB), DO_FP8 ? 1.0f / (AO8_SCALE * WDO_SCALE) : 1.0f};
                pg8::gemm_phase<pg8::DenseProb<1024, 1, DO_FP8 != 0>, pg8::EpiDelta, true>(F.lds, P, E);
                AFTER(pb + 4);
            }
        } else {
            bf16* RQ = (bf16*)(ws + WS_PROJ); bf16* RKF = (bf16*)(ws + WS_PROJ + 128 * MiB); bf16* RKB = (bf16*)(ws + WS_PROJ + 256 * MiB); bf16* RV = (bf16*)(ws + WS_PROJ + 384 * MiB); bf16* RG = (bf16*)(ws + WS_PROJ + 640 * MiB);
            bf16* RP = (bf16*)(ws + WS_RP);
            if (PHM(4) && RUN(pb + 0)) { for (int rep_ = 0; rep_ < REPS(4); ++rep_) { if (rep_) xcd_barrier(bar);
                pg8::DenseProb<1024, 1, RET_FP8 != 0> P{RET_FP8 ? (const void*)(ws + WS_HB8) : (const void*)HB, RET_FP8 ? (const void*)(ws + WS_WRI + (size_t)jl * 6144 * 1024) : (const void*)((const bf16*)(ws + WS_WRI) + (size_t)jl * 6144 * 1024), NTOK / 256, 24, F.G, F.vcu};
                pg8::EpiRetIn E{RQ, RKF, RKB, RV, RG, a.lgf + jl * 4, a.lgb + jl * 4, RET_FP8 ? 1.0f / (H8_SCALE * WRI_SCALE) : 1.0f};
                pg8::gemm_phase<pg8::DenseProb<1024, 1, RET_FP8 != 0>, pg8::EpiRetIn, true>(F.lds, P, E);
                } AFTER(pb + 0);
            }
            if (PHM(5) && RUN(pb + 1)) { for (int rep_ = 0; rep_ < REPS(5); ++rep_) { if (rep_) xcd_barrier(bar);
                const int gw = F.vcu * 8 + F.wave, NGW = F.G * 8;
                for (int u = gw; u < NBATCH * 4 * 128; u += NGW) { const int sc = u & 127, h = (u >> 7) & 3, b = u >> 9; ret::rp_unit(b, h, sc, RQ, RKF, RKB, RP, a.lgf[jl * 4 + h], a.lgb[jl * 4 + h]); }
                } AFTER(pb + 1);
            }
            if (PHM(6) && RUN(pb + 2)) { for (int rep_ = 0; rep_ < REPS(6); ++rep_) { if (rep_) xcd_barrier(bar);
                for (int u = F.vcu; u < NBATCH * 4 * 2 * 2; u += F.G) { const int vs = u & 1, dir = (u >> 1) & 1, h = (u >> 2) & 3, b = u >> 4;
                    ret::ChainArgs A{RQ, dir ? RKB : RKF, RV, RP, (bf16*)(ws + (dir ? WS_ROB : WS_ROF)), dir ? a.lgb[jl * 4 + h] : a.lgf[jl * 4 + h]};
                    ret::chain_unit(b, h, dir, vs, A, (LAS char*)F.lds); }
                } AFTER(pb + 2);
            }
            if (PHM(7) && RUN(pb + 3)) { for (int rep_ = 0; rep_ < REPS(7); ++rep_) { if (rep_) xcd_barrier(bar); td_phase(F, a); } AFTER(pb + 3); }
            if (PHM(8) && RUN(pb + 4)) {
                pg8::DenseProb<2048, 1, RO_FP8 != 0> P{(const void*)(ws + WS_RGO), RO_FP8 ? (const void*)(ws + WS_WRO + (size_t)jl * 1024 * 2048) : (const void*)((const bf16*)(ws + WS_WRO) + (size_t)jl * 1024 * 2048), NTOK / 256, 4, F.G, F.vcu};
                pg8::EpiDelta E{(bf16*)(ws + WS_XB), RO_FP8 ? 1.0f / (GO8_SCALE * WRO_SCALE) : 1.0f};
                pg8::gemm_phase<pg8::DenseProb<2048, 1, RO_FP8 != 0>, pg8::EpiDelta, true>(F.lds, P, E);
                AFTER(pb + 4);
            }
        }
        const int* cnt = (const int*)(ws + WS_CTL) + CW_CNT + i * NEXP;
        if (PHM(9) && RUN(pb + 5)) {
            if (REPS(9) == 2) { tb_phase(F, a, i); xcd_barrier(bar); { const int t_ = opaque_tid(); if (blockIdx.x == 0 && t_ < NEXP) ((GAS int*)(ws + WS_CTL))[CW_CNT + i * NEXP + t_] = 0; } xcd_barrier(bar); }
            tb_phase(F, a, i); AFTER(pb + 5); }
        if (PHM(10) && RUN(pb + 6)) { for (int rep_ = 0; rep_ < REPS(10); ++rep_) { if (rep_) xcd_barrier(bar);
            compute_toff(F, cnt);
            pg8::MoeProb<1024, true, 3> P{ws + WS_HB8, ws + WS_W1 + (size_t)i * NEXP * 2048 * 1024, (size_t)2048 * 1024, (const int*)(ws + WS_LIST), cnt, F.misc + MI_TOFF, 8, F.G, F.vcu};
            pg8::EpiSwiglu E{ws + WS_ACT, a.moe_b1 + (size_t)i * NEXP * 2048, (const float*)(ws + WS_LRS), 1.0f / (H8U_SCALE * W1_SCALE)};
            pg8::gemm_phase<pg8::MoeProb<1024, true, 3>, pg8::EpiSwiglu, MOE_ALIGN>(F.lds, P, E);
            } AFTER(pb + 6);
        }
        if (PHM(11) && RUN(pb + 7)) { for (int rep_ = 0; rep_ < REPS(11); ++rep_) { if (rep_) xcd_barrier(bar);
            if (!(PHM(10) && RUN(pb + 6))) compute_toff(F, cnt);
            pg8::MoeProb<1024, false, 1> P{ws + WS_ACT, ws + WS_W2 + (size_t)i * NEXP * 1024 * 1024, (size_t)1024 * 1024, (const int*)(ws + WS_LIST), cnt, F.misc + MI_TOFF, 4, F.G, F.vcu};
            pg8::EpiBias E{(void*)(ws + WS_Y), a.moe_b2 + (size_t)i * NEXP * 1024, 1.0f / (W2_SCALE * ACT8_SCALE)};
            pg8::gemm_phase<pg8::MoeProb<1024, false, 1>, pg8::EpiBias, MOE_ALIGN>(F.lds, P, E);
            } AFTER(pb + 7);
        }
        if (PHM(12) && RUN(pb + 8)) {
            if (!(PHM(10) && RUN(pb + 6))) compute_toff(F, cnt);
            const float* gain = (i == DEPTH - 1) ? nullptr : ((i & 1) == 0 ? a.ret_norm + (size_t)jl * DM : a.diff_norm + (size_t)(jl + 1) * DM);
            if (REPS(12) == 2) { tc_phase(F, a, i == DEPTH - 1, gain, (i & 1) == 0 ? (RET_FP8 != 0) : (QKV_FP8 != 0), true); xcd_barrier(bar); }
            tc_phase(F, a, i == DEPTH - 1, gain, (i & 1) == 0 ? (RET_FP8 != 0) : (QKV_FP8 != 0));
            AFTER(pb + 8);
        }
    }
#undef RUN
#undef AFTER
}

#ifndef MK_PER_PHASE
#define MK_PER_PHASE 0
#endif
extern "C" void kernel_launch(void* const* d_in, const int* in_sizes, int n_in, void* d_out, int out_size, void* d_ws, size_t ws_size, hipStream_t stream) {
    static int grid = 0;
    if (grid == 0) {
        if (n_in != 23 || in_sizes[0] != NTOK * DM || out_size != NTOK * DM || ws_size < WS_END) { fprintf(stderr, "kernel_launch: unexpected shapes (n_in %d, in0 %d, out %d, ws %zu); nothing launched\n", n_in, n_in > 0 ? in_sizes[0] : -1, out_size, ws_size); grid = -1; return; }
        int dev = 0, cus = 0, per_cu = 0;
        if (hipGetDevice(&dev) != hipSuccess || hipDeviceGetAttribute(&cus, hipDeviceAttributeMultiprocessorCount, dev) != hipSuccess) { fprintf(stderr, "kernel_launch: device query failed\n"); grid = -1; return; }
        if (hipFuncSetAttribute((const void*)fwd_kernel, hipFuncAttributeMaxDynamicSharedMemorySize, LDS_BYTES) != hipSuccess) { fprintf(stderr, "kernel_launch: hipFuncSetAttribute failed\n"); grid = -1; return; }
        if (hipOccupancyMaxActiveBlocksPerMultiprocessor(&per_cu, (const void*)fwd_kernel, 512, LDS_BYTES) != hipSuccess || per_cu < 1) fprintf(stderr, "kernel_launch: note: occupancy query reports %d workgroups per CU\n", per_cu);
        (void)hipGetLastError();
        grid = cus;
    }
    if (grid < 0) return;
    if (hipMemsetAsync((char*)d_ws + WS_CTL, 0, CTL_ZERO_BYTES, stream) != hipSuccess) { fprintf(stderr, "kernel_launch: memset failed\n"); return; }
    Args a{};
    const float** ap = (const float**)&a;
    for (int i = 0; i < 23; ++i) ap[i] = (const float*)d_in[i];
    a.out = (float*)d_out; a.ws = (unsigned char*)d_ws;
#if MK_PER_PHASE
    for (int p = 0; p < N_PHASES; ++p) {
        if (p > 0) { const int i = (p - 1) / 9, k = (p - 1) % 9; if ((i & 1) == 0 && (k == 1 || k == 3)) continue; }
        a.ph_lo = p; a.ph_hi = p + 1;
        hipLaunchKernelGGL(fwd_kernel, dim3(grid), dim3(512), LDS_BYTES, stream, a);
    }
#else
    a.ph_lo = 0; a.ph_hi = N_PHASES;
    hipLaunchKernelGGL(fwd_kernel, dim3(grid), dim3(512), LDS_BYTES, stream, a);
#endif
    const hipError_t le = hipPeekAtLastError();
    if (le != hipSuccess) fprintf(stderr, "kernel_launch: launch failed: %s\n", hipGetErrorName(le));
}
```

```cpp
#include <hip/hip_runtime.h>
#include <cstdio>
#include <cstdint>

#define GAS __attribute__((address_space(1)))
#define LAS __attribute__((address_space(3)))
typedef unsigned short bf16;
typedef unsigned v4u __attribute__((ext_vector_type(4)));
typedef unsigned v2u __attribute__((ext_vector_type(2)));
typedef float f32x4 __attribute__((ext_vector_type(4)));
typedef float f32x2 __attribute__((ext_vector_type(2)));
typedef float f32x16 __attribute__((ext_vector_type(16)));
typedef short bf16x8 __attribute__((ext_vector_type(8)));
typedef short s16x4 __attribute__((ext_vector_type(4)));
typedef __bf16 bf16x2_t __attribute__((ext_vector_type(2)));
typedef GAS unsigned gu32;

constexpr int NTOK = 65536, DM = 1024, SEQ = 4096, NBATCH = 16, DEPTH = 4;
constexpr int NEXP = 32, TOPK = 4, FF = 1024;
constexpr int RET_VW = 2048;
constexpr float NORM_EPS = 1e-5f;
constexpr float LOG2E = 1.4426950408889634f;

__device__ __forceinline__ unsigned cvtpk(float lo, float hi) { f32x2 v = {lo, hi}; bf16x2_t b = __builtin_convertvector(v, bf16x2_t); return __builtin_bit_cast(unsigned, b); }
__device__ __forceinline__ float bflo(unsigned u) { return __uint_as_float(u << 16); }
__device__ __forceinline__ float bfhi(unsigned u) { return __uint_as_float(u & 0xffff0000u); }
extern __shared__ __attribute__((aligned(16))) unsigned char lds_raw[];
constexpr int WTAB_BYTES = 147456 + 4 * 192;
__device__ __forceinline__ int lane_now() { int l; asm volatile("v_mbcnt_lo_u32_b32 %0, -1, 0\n\tv_mbcnt_hi_u32_b32 %0, -1, %0" : "=v"(l)); return l; }
__device__ __forceinline__ unsigned hw_wave_slot() { return (unsigned)__builtin_amdgcn_s_getreg((5 << 11) | 4) & 63u; }
__device__ __forceinline__ int opaque_tid() {
    const int w = __builtin_amdgcn_readfirstlane(*(const LAS int*)((LAS unsigned char*)lds_raw + WTAB_BYTES + 4 * hw_wave_slot()));
    int t = w * 64 + lane_now(); asm volatile("" : "+v"(t)); return t; }
__device__ __forceinline__ float shfl_xor_(float v, int m, int lane) { return __uint_as_float((unsigned)__builtin_amdgcn_ds_bpermute((lane ^ m) << 2, (int)__float_as_uint(v))); }
__device__ __forceinline__ float shfl_idx_(float v, int idx) { return __uint_as_float((unsigned)__builtin_amdgcn_ds_bpermute(idx << 2, (int)__float_as_uint(v))); }
template <class T> __device__ __forceinline__ T* opaque_ptr(T* p) { asm volatile("" : "+s"(p)); return p; }
__device__ __forceinline__ float wave_sum(float v) {
    const int l_ = lane_now();
#pragma unroll
    for (int o = 1; o < 64; o <<= 1) v += shfl_xor_(v, o, l_);
    return v;
}

namespace pg8 {
constexpr int BM = 256, BK = 64, HALF = 128, HTB = HALF * BK * 2  , STAGE_BYTES = 8 * HTB;

__host__ __device__ __forceinline__ int lds_byte(int r, int c) { const int st = (r >> 4) * 2 + (c >> 5), rr = r & 15, cc = c & 31, ob = rr * 64 + cc * 2; return st * 1024 + (ob ^ (((ob >> 9) & 1) << 5)); }
__host__ __device__ __forceinline__ void stage_rc(int b, int& R, int& C) { const int st = b / 1024, sb = b % 1024, swz = sb ^ (((sb >> 9) & 1) << 5); R = (st >> 1) * 16 + swz / 64; C = (st & 1) * 32 + (swz % 64) / 2; }
__host__ __device__ __forceinline__ int perm32(int rho) { const int n = rho >> 4, i = rho & 15; return 8 * (i >> 2) + 4 * n + (i & 3); }

typedef int v8i __attribute__((ext_vector_type(8)));
__device__ __forceinline__ v8i cat16(bf16x8 a, bf16x8 b) { const v4u x = __builtin_bit_cast(v4u, a), y = __builtin_bit_cast(v4u, b); return (v8i){(int)x.x, (int)x.y, (int)x.z, (int)x.w, (int)y.x, (int)y.y, (int)y.z, (int)y.w}; }
__device__ __forceinline__ void mfma_fp8_acc(f32x4& c, v8i a, v8i b, int sc1) {
    asm volatile("v_mfma_scale_f32_16x16x128_f8f6f4 %0, %1, %2, %0, %3, %3 op_sel_hi:[0,0,0]" : "+v"(c) : "v"(a), "v"(b), "v"(sc1));
}
constexpr int TEXP_REL = 8192 - 64;
constexpr int LISTPARK_OFF = 147456 + 4096;
constexpr int PARK_OFF = 147456 + 12288;
__device__ __forceinline__ void glds4(const GAS void* gsrc, unsigned lds_dst) { unsigned keep;
    asm volatile("s_mov_b32 %0, m0\n\ts_mov_b32 m0, %2\n\ts_nop 0\n\tglobal_load_lds_dword %1, off\n\ts_mov_b32 m0, %0" : "=&s"(keep) : "v"(gsrc), "s"(lds_dst) : "memory"); }
struct Unit { int pm, pn, e, lt; };

__device__ __forceinline__ void order_map(long L, int nN, int& pm, int& pn) {
    const int grp = (int)(L >> 5), w = (int)(L & 31), ncg = nN >> 2;
    pm = (grp / ncg) * 8 + (w & 7); pn = (grp % ncg) * 4 + (w >> 3);
}

template <int K_, int BMODE_, bool FP8_ = false> struct DenseProb {
    static constexpr int K = K_, BMODE = BMODE_, PB = FP8_ ? K_ : 2 * K_; static constexpr bool GATHER = false, FP8 = FP8_;
    const void* A; const void* Bt; int nM, nN, G, c;
    __device__ __forceinline__ bool next(int i, Unit& u) const {
        const long L = (long)i * G + c; if (L >= (long)nM * nN) return false;
        order_map(L, nN, u.pm, u.pn); u.e = 0; u.lt = 0; return true; }
    __device__ __forceinline__ const char* a_base(const Unit& u) const { return (const char*)A + (size_t)u.pm * ((size_t)BM * PB); }
    __device__ __forceinline__ const char* b_base(const Unit& u) const { return (const char*)Bt + (size_t)u.pn * ((size_t)BM * PB); }
    template <int NH> __device__ __forceinline__ void a_rows(const Unit&, int, unsigned (&)[NH][2]) const {}
    __device__ __forceinline__ void pre_rows(const Unit&, int, int, unsigned) const {}
    template <int NH> __device__ __forceinline__ void a_rows_lds(const Unit&, unsigned, unsigned (&)[NH][2], const LAS int*) const {}
};
template <int K_, bool GATHER_, int BMODE_> struct MoeProb {
    static constexpr int K = K_, BMODE = BMODE_, PB = K_; static constexpr bool GATHER = GATHER_, FP8 = true;
    const unsigned char* A; const unsigned char* Bt; size_t bstride;
    const int* list; const int* cnt; const LAS int* toff; int nN, G, c;
    __device__ __forceinline__ bool next(int i, Unit& u) const {
        const int TM = toff[32], TM8 = (TM + 7) & ~7; const long L = (long)i * G + c; if (L >= (long)TM8 * nN) return false;
        int gm, pn; order_map(L, nN, gm, pn); if (gm >= TM) gm = TM - 1;
        const int e = __builtin_amdgcn_readfirstlane((int)((const LAS unsigned char*)toff + TEXP_REL)[gm]);
        u.pm = gm; u.pn = pn; u.e = e; u.lt = gm - toff[e]; return true; }
    __device__ __forceinline__ const char* a_base(const Unit& u) const { return GATHER ? (const char*)A : (const char*)A + (size_t)u.pm * ((size_t)BM * PB); }
    __device__ __forceinline__ const char* b_base(const Unit& u) const { return (const char*)Bt + (size_t)u.e * bstride + (size_t)u.pn * ((size_t)BM * PB); }
    __device__ __forceinline__ void pre_rows(const Unit& u, int wid, int lane, unsigned park) const {
        if (wid < 4) glds4((const GAS void*)(list + (size_t)u.e * NTOK + u.lt * 256 + 64 * wid + lane), park + 256u * (unsigned)wid); }
    template <int NH> __device__ __forceinline__ void a_rows_lds(const Unit& u, unsigned c2, unsigned (&off)[NH][2], const LAS int* park) const {
        const int n = toff[128 + u.e] - u.lt * 256;
        int R, C; stage_rc(opaque_tid() * 16, R, C);
#pragma unroll
        for (int h = 0; h < NH; ++h)
#pragma unroll
            for (int i = 0; i < 2; ++i) { const int idx = h * 128 + i * 64 + R; int tok = park[idx]; if (idx >= n) tok = 0;
                off[h][i] = (unsigned)tok * (unsigned)PB + c2; }
    }
    template <int NH> __device__ __forceinline__ void a_rows(const Unit& u, int tid, unsigned (&off)[NH][2]) const {
        const int n = ((const GAS int*)cnt)[u.e]; const GAS int* le = (const GAS int*)list + (size_t)u.e * NTOK;
        asm volatile("" : "+v"(tid));
#pragma unroll
        for (int h = 0; h < NH; ++h)
#pragma unroll
            for (int i = 0; i < 2; ++i) { int R, C; stage_rc(tid * 16 + i * 8192, R, C); int pos = u.lt * 256 + h * 128 + R; if (pos >= n) pos = 0; const int tok = le[pos]; off[h][i] = (unsigned)tok * (unsigned)PB + (unsigned)(C * 2); }
    }
};

template <class Prob, class Epi, bool ALIGN_EPI>
__device__ __forceinline__ void gemm_phase(LAS unsigned char* lds, const Prob& S, const Epi& E) {
    const int tid = opaque_tid(), wid = __builtin_amdgcn_readfirstlane(tid >> 6), lane = tid & 63, wr = wid >> 2, wc = wid & 3, fr = lane & 15, fq = lane >> 4;
    constexpr int PB = Prob::PB, nt = PB / 128;
    constexpr int NH = Prob::GATHER ? 2 : 1;
    unsigned voffB[2], coffA[NH][2], noffA[NH][2];
    constexpr size_t kstep = (size_t)(BK * 2);
    constexpr size_t hstepA = (size_t)HALF * PB;
    constexpr size_t hstepB = (size_t)(Prob::BMODE == 2 ? 32 : (Prob::BMODE == 3 ? 8 : HALF)) * PB;
#pragma unroll
    for (int i = 0; i < 2; ++i) { int R, C; stage_rc(tid * 16 + i * 8192, R, C);
        const int Rb = Prob::BMODE == 0 ? R : (Prob::BMODE == 1 ? ((R & ~31) + perm32(R & 31)) : (Prob::BMODE == 2 ? (64 * (R >> 5) + perm32(R & 31)) : (64 * (R >> 5) + 16 * ((R & 15) >> 2) + 4 * ((R >> 4) & 1) + (R & 3))));
        voffB[i] = (unsigned)(Rb * PB + C * 2);
#pragma unroll
        for (int h = 0; h < NH; ++h) { coffA[h][i] = (unsigned)(R * PB + C * 2); noffA[h][i] = coffA[h][i]; } }
    const unsigned ldsw = (unsigned)wid * 1024u;
    const int aoff = lds_byte(wr * 64 + fr, fq * 8), boff = lds_byte(wc * 32 + fr, fq * 8);
#define PG8_SA(b, h) (((b) * 2 + (h)) * HTB)
#define PG8_SB(b, h) ((4 + (b) * 2 + (h)) * HTB)
#define PG8_STAGE_A(bufoff, gbase, h, arr) do { _Pragma("unroll") for (int _i = 0; _i < 2; ++_i) \
        __builtin_amdgcn_global_load_lds((const unsigned*)((const char*)(gbase) + (Prob::GATHER ? (size_t)0 : (size_t)(h) * hstepA) + (arr)[Prob::GATHER ? (h) : 0][_i]), (LAS unsigned*)(lds + (bufoff) + ldsw + _i * 8192), 16, 0, 0); } while (0)
#define PG8_STAGE(bufoff, gbase, voff) do { _Pragma("unroll") for (int _i = 0; _i < 2; ++_i) \
        __builtin_amdgcn_global_load_lds((const unsigned*)((const char*)(gbase) + (voff)[_i]), (LAS unsigned*)(lds + (bufoff) + ldsw + _i * 8192), 16, 0, 0); } while (0)
#define PG8_LDA(dst, b, h) do { _Pragma("unroll") for (int m = 0; m < 4; ++m) _Pragma("unroll") for (int k = 0; k < 2; ++k) dst[m][k] = *(const LAS bf16x8*)(lds + PG8_SA(b, h) + aoff + m * 2048 + k * 1024); } while (0)
#define PG8_LDB(dst, b, h) do { _Pragma("unroll") for (int n = 0; n < 2; ++n) _Pragma("unroll") for (int k = 0; k < 2; ++k) dst[n][k] = *(const LAS bf16x8*)(lds + PG8_SB(b, h) + boff + n * 2048 + k * 1024); } while (0)
#define PG8_MMA(ai, bj, At, Bt) do { __builtin_amdgcn_s_setprio(1); _Pragma("unroll") for (int m = 0; m < 4; ++m) _Pragma("unroll") for (int n = 0; n < 2; ++n) { \
        if constexpr (Prob::FP8) mfma_fp8_acc(acc[ai][bj][m][n], cat16(Bt[n][0], Bt[n][1]), cat16(At[m][0], At[m][1]), sc1); \
        else { _Pragma("unroll") for (int k = 0; k < 2; ++k) acc[ai][bj][m][n] = __builtin_amdgcn_mfma_f32_16x16x32_bf16(Bt[n][k], At[m][k], acc[ai][bj][m][n], 0, 0, 0); } } \
        __builtin_amdgcn_s_setprio(0); } while (0)
#define PG8_WAIT_V(n) asm volatile("s_waitcnt vmcnt(" #n ")" ::: "memory")
#define PG8_WAIT_L(n) asm volatile("s_waitcnt lgkmcnt(" #n ")" ::: "memory")
#define PG8_BAR __builtin_amdgcn_s_barrier()
#define PG8_SCHED __builtin_amdgcn_sched_barrier(0)
    int sc1 = 0x7f7f7f7f; asm volatile("" : "+v"(sc1));
    Unit cur, nxt; int ui = 0;
    if (!S.next(0, cur)) return;
    if constexpr (Epi::PARK) E.pre(cur, wid, lane, (unsigned)__builtin_amdgcn_readfirstlane((unsigned)(size_t)(lds + PARK_OFF)));
    f32x4 acc[2][2][4][2];
#pragma unroll
    for (int a = 0; a < 2; ++a)
#pragma unroll
        for (int b = 0; b < 2; ++b)
#pragma unroll
            for (int m = 0; m < 4; ++m)
#pragma unroll
                for (int n = 0; n < 2; ++n) acc[a][b][m][n] = (f32x4){0.f, 0.f, 0.f, 0.f};
    bf16x8 At[4][2], B0[2][2], B1[2][2];
    const char* cA = S.a_base(cur); const char* cB = S.b_base(cur);
    if constexpr (Prob::GATHER) { S.template a_rows<NH>(cur, tid, coffA); PG8_WAIT_V(0); }
    PG8_STAGE(PG8_SB(0, 0), cB, voffB); PG8_STAGE(PG8_SB(0, 1), cB + hstepB, voffB); PG8_STAGE_A(PG8_SA(0, 0), cA, 0, coffA); PG8_STAGE_A(PG8_SA(0, 1), cA, 1, coffA);
    if (wr == 1) PG8_BAR;
    PG8_WAIT_V(2); PG8_BAR;
    PG8_STAGE(PG8_SB(1, 0), cB + kstep, voffB); PG8_STAGE_A(PG8_SA(1, 0), cA + kstep, 0, coffA); PG8_STAGE(PG8_SB(1, 1), cB + hstepB + kstep, voffB);
    PG8_WAIT_V(6); PG8_BAR;
    for (;;) {
        const bool has_next = S.next(ui + 1, nxt);
        const char* nA = has_next ? S.a_base(nxt) : cA; const char* nB = has_next ? S.b_base(nxt) : cB;
        if constexpr (Prob::GATHER) {
            { Unit n2; if (S.next(ui + 2, n2)) S.pre_rows(n2, wid, lane, (unsigned)__builtin_amdgcn_readfirstlane((unsigned)(size_t)(lds + LISTPARK_OFF + ((ui + 2) % 3) * 1024))); }
            if (has_next) {
                if (ui == 0) { S.template a_rows<NH>(nxt, tid, noffA); PG8_WAIT_V(0); }
                else S.template a_rows_lds<NH>(nxt, coffA[0][0] & (unsigned)(PB - 1), noffA, (const LAS int*)(lds + LISTPARK_OFF + ((ui + 1) % 3) * 1024)); }
            else {
#pragma unroll
                for (int h = 0; h < NH; ++h)
#pragma unroll
                    for (int i = 0; i < 2; ++i) noffA[h][i] = coffA[h][i]; }
        }
#pragma unroll 1
        for (int t = 0; t < nt; t += 2) {
            const bool last = (t == nt - 2);
#ifdef DRAIN_PROBE
            if (Prob::FP8 && t == nt / 2) PG8_WAIT_V(0);
#endif
            const char* a1 = cA + (size_t)(t + 1) * kstep;
            const char* a2 = last ? nA : cA + (size_t)(t + 2) * kstep; const char* b2 = last ? nB : cB + (size_t)(t + 2) * kstep;
            const char* a3 = a2 + kstep; const char* b3 = b2 + kstep;
            PG8_LDB(B0, 0, 0); PG8_LDB(B1, 0, 1); PG8_SCHED; PG8_LDA(At, 0, 0); PG8_STAGE_A(PG8_SA(1, 1), a1, 1, coffA);
            if constexpr (Prob::GATHER) { if (last) {
#pragma unroll
                for (int h = 0; h < NH; ++h)
#pragma unroll
                    for (int i = 0; i < 2; ++i) coffA[h][i] = noffA[h][i]; } }
            PG8_WAIT_V(8); PG8_WAIT_L(0); PG8_BAR; PG8_MMA(0, 0, At, B0); PG8_MMA(0, 1, At, B1); PG8_BAR; PG8_SCHED;
            PG8_LDA(At, 0, 1); PG8_STAGE(PG8_SB(0, 0), b2, voffB); PG8_STAGE(PG8_SB(0, 1), b2 + hstepB, voffB); PG8_STAGE_A(PG8_SA(0, 0), a2, 0, coffA);
            PG8_WAIT_V(8); PG8_WAIT_L(0); PG8_BAR; PG8_MMA(1, 0, At, B0); PG8_MMA(1, 1, At, B1); PG8_BAR; PG8_SCHED;
            PG8_LDB(B0, 1, 0); PG8_LDB(B1, 1, 1); PG8_SCHED; PG8_LDA(At, 1, 0); PG8_STAGE_A(PG8_SA(0, 1), a2, 1, coffA);
            PG8_WAIT_V(8); PG8_WAIT_L(0); PG8_BAR; PG8_MMA(0, 0, At, B0); PG8_MMA(0, 1, At, B1); PG8_BAR; PG8_SCHED;
            PG8_LDA(At, 1, 1); PG8_STAGE(PG8_SB(1, 0), b3, voffB); PG8_STAGE(PG8_SB(1, 1), b3 + hstepB, voffB); PG8_STAGE_A(PG8_SA(1, 0), a3, 0, coffA);
            PG8_WAIT_V(8); PG8_WAIT_L(0); PG8_BAR; PG8_MMA(1, 0, At, B0); PG8_MMA(1, 1, At, B1); PG8_BAR; PG8_SCHED;
        }
        if constexpr (Prob::FP8) asm volatile("s_nop 15\n\ts_nop 15" ::: "memory");
        if constexpr (ALIGN_EPI) { if (wr == 0) PG8_BAR; }
        if constexpr (Epi::PARK) E(acc, cur, wr, wc, fr, fq, (const LAS float*)(lds + PARK_OFF + (ui & 1) * 2048)); else E(acc, cur, wr, wc, fr, fq);
        if (!has_next) break;
#pragma unroll
        for (int a = 0; a < 2; ++a)
#pragma unroll
            for (int b = 0; b < 2; ++b)
#pragma unroll
                for (int m = 0; m < 4; ++m)
#pragma unroll
                    for (int n = 0; n < 2; ++n) acc[a][b][m][n] = (f32x4){0.f, 0.f, 0.f, 0.f};
        cur = nxt; cA = nA; cB = nB; ++ui;
        if constexpr (Epi::PARK) E.pre(cur, wid, lane, (unsigned)__builtin_amdgcn_readfirstlane((unsigned)(size_t)(lds + PARK_OFF + (ui & 1) * 2048)));
        if constexpr (Prob::GATHER) {
#pragma unroll
            for (int h = 0; h < NH; ++h)
#pragma unroll
                for (int i = 0; i < 2; ++i) coffA[h][i] = noffA[h][i]; }
        if constexpr (ALIGN_EPI) { if (wr == 1) PG8_BAR; }
    }
    PG8_WAIT_V(0);
    if constexpr (!ALIGN_EPI) { if (wr == 0) PG8_BAR; }
    PG8_BAR;
#undef PG8_SA
#undef PG8_SB
#undef PG8_STAGE
#undef PG8_STAGE_A
#undef PG8_LDA
#undef PG8_LDB
#undef PG8_MMA
#undef PG8_WAIT_V
#undef PG8_WAIT_L
#undef PG8_BAR
#undef PG8_SCHED
}
}

#ifndef Y_FP8
#define Y_FP8 1
#endif
constexpr float Y8_SCALE = 16.0f, ACT8_SCALE = 4.0f;
namespace pg8 {
struct EpiQKV {
    static constexpr bool PARK = true;
    bf16* Qo; bf16* Ko; bf16* Vo; const float* qg; const float* kg; float sc;
    __device__ __forceinline__ void pre(const Unit& u, int wid, int lane, unsigned park) const {
        if (wid == 0 && u.pn < 8) glds4((const GAS void*)((u.pn < 4 ? qg : kg) + lane), park); }
    __device__ __forceinline__ void operator()(const f32x4 (&acc)[2][2][4][2], const Unit& u, int wr, int wc, int fr, int fq, const LAS float* park) const {
        const int sec = u.pn >> 2; const int colt = (u.pn & 3) * 256 + wc * 64 + 8 * fq;
        bf16* base = Qo + (size_t)sec * ((size_t)NTOK * DM);
        const int row0 = u.pm * 256 + wr * 64 + fr;
        const float sc = sec == 0 ? (0.125f * LOG2E) : 1.f;
        f32x4 gv[2][2];
#pragma unroll
        for (int bj = 0; bj < 2; ++bj)
#pragma unroll
            for (int n = 0; n < 2; ++n) gv[bj][n] = sec < 2 ? *(const LAS f32x4*)(park + 32 * bj + 8 * fq + 4 * n) : (f32x4){1.f, 1.f, 1.f, 1.f};
#pragma unroll
        for (int ai = 0; ai < 2; ++ai)
#pragma unroll
            for (int m = 0; m < 4; ++m) {
                float rs = 1.f;
                if (sec < 2) { float ss = 0.f;
#pragma unroll
                    for (int bj = 0; bj < 2; ++bj)
#pragma unroll
                        for (int n = 0; n < 2; ++n) { const f32x4 x = acc[ai][bj][m][n]; ss += (x[0] * x[0] + x[1] * x[1]) + (x[2] * x[2] + x[3] * x[3]); }
                    { const int l_ = lane_now(); ss += shfl_xor_(ss, 16, l_); ss += shfl_xor_(ss, 32, l_); }
                    rs = __builtin_amdgcn_rsqf(ss * (sc * sc * (1.0f / 64.0f)) + NORM_EPS) * sc; }
                bf16* rowp = base + (size_t)(row0 + ai * 128 + m * 16) * DM + colt;
#pragma unroll
                for (int bj = 0; bj < 2; ++bj) { f32x4 g0 = (f32x4){sc, sc, sc, sc}, g1 = g0;
                    if (sec < 2) { g0 = gv[bj][0] * (rs * sc); g1 = gv[bj][1] * (rs * sc); }
                    const f32x4 v0 = acc[ai][bj][m][0] * g0, v1 = acc[ai][bj][m][1] * g1;
                    v4u w; w.x = cvtpk(v0[0], v0[1]); w.y = cvtpk(v0[2], v0[3]); w.z = cvtpk(v1[0], v1[1]); w.w = cvtpk(v1[2], v1[3]);
                    *(GAS v4u*)(rowp + 32 * bj) = w; }
                asm volatile("" ::: "memory");
            }
    }
};
struct EpiRetIn {
    static constexpr bool PARK = false;
    bf16 *Qo, *KFo, *KBo, *Vo, *Go; const float* lgf; const float* lgb; float sc;
    __device__ __forceinline__ void operator()(const f32x4 (&acc)[2][2][4][2], const Unit& u, int wr, int wc, int fr, int fq) const {
        const int pn = u.pn; const int row0 = u.pm * 256 + wr * 64 + fr; const int cw = wc * 32 + 8 * fq;
        if (pn >= 4 && pn < 8) {
            const int hd = pn - 4; const float lf = ((const GAS float*)lgf)[hd], lb = ((const GAS float*)lgb)[hd];
            float zf[2], zb[2];
#pragma unroll
            for (int mm = 0; mm < 2; ++mm) { const float i32 = (float)(16 * mm + fr); zf[mm] = __expf(lf * (31.0f - i32)) * 0.0625f * sc; zb[mm] = __expf(lb * i32) * 0.0625f * sc; }
#pragma unroll
            for (int ai = 0; ai < 2; ++ai)
#pragma unroll
                for (int m = 0; m < 4; ++m) { const size_t off = (size_t)(row0 + ai * 128 + m * 16) * 1024 + hd * 256 + cw;
#pragma unroll
                    for (int bj = 0; bj < 2; ++bj) { const f32x4 a0 = acc[ai][bj][m][0], a1 = acc[ai][bj][m][1]; const float f = zf[m & 1], b = zb[m & 1];
                        v4u w; w.x = cvtpk(a0[0] * f, a0[1] * f); w.y = cvtpk(a0[2] * f, a0[3] * f); w.z = cvtpk(a1[0] * f, a1[1] * f); w.w = cvtpk(a1[2] * f, a1[3] * f);
                        *(GAS v4u*)(KFo + off + 128 * bj) = w;
                        w.x = cvtpk(a0[0] * b, a0[1] * b); w.y = cvtpk(a0[2] * b, a0[3] * b); w.z = cvtpk(a1[0] * b, a1[1] * b); w.w = cvtpk(a1[2] * b, a1[3] * b);
                        *(GAS v4u*)(KBo + off + 128 * bj) = w; } }
        } else {
            bf16* base; int ld, ct;
            if (pn < 4) { base = Qo; ld = 1024; ct = pn; } else if (pn < 16) { base = Vo; ld = 2048; ct = pn - 8; } else { base = Go; ld = 2048; ct = pn - 16; }
#pragma unroll
            for (int ai = 0; ai < 2; ++ai)
#pragma unroll
                for (int m = 0; m < 4; ++m) { bf16* rowp = base + (size_t)(row0 + ai * 128 + m * 16) * ld + ct * 256 + cw;
#pragma unroll
                    for (int bj = 0; bj < 2; ++bj) { const f32x4 a0 = acc[ai][bj][m][0] * sc, a1 = acc[ai][bj][m][1] * sc;
                        v4u w; w.x = cvtpk(a0[0], a0[1]); w.y = cvtpk(a0[2], a0[3]); w.z = cvtpk(a1[0], a1[1]); w.w = cvtpk(a1[2], a1[3]);
                        *(GAS v4u*)(rowp + 128 * bj) = w; } }
        }
    }
};
struct EpiResid {
    static constexpr bool PARK = false;
    const float* resid; float* out;
    __device__ __forceinline__ void operator()(const f32x4 (&acc)[2][2][4][2], const Unit& u, int wr, int wc, int fr, int fq) const {
        const int row0 = u.pm * 256 + wr * 64 + fr, col0 = u.pn * 256 + wc * 32 + 4 * fq;
#pragma unroll
        for (int ai = 0; ai < 2; ++ai)
#pragma unroll
            for (int m = 0; m < 4; ++m) { const size_t off = (size_t)(row0 + ai * 128 + m * 16) * DM + col0;
                f32x4 r[2][2];
#pragma unroll
                for (int bj = 0; bj < 2; ++bj)
#pragma unroll
                    for (int n = 0; n < 2; ++n) r[bj][n] = *(const GAS f32x4*)(resid + off + bj * 128 + n * 16);
#pragma unroll
                for (int bj = 0; bj < 2; ++bj)
#pragma unroll
                    for (int n = 0; n < 2; ++n) *(GAS f32x4*)(out + off + bj * 128 + n * 16) = r[bj][n] + acc[ai][bj][m][n];
                if (m & 1) asm volatile("" ::: "memory"); }
    }
};
struct EpiDelta {
    static constexpr bool PARK = false;
    bf16* d; float sc;
    __device__ __forceinline__ void operator()(const f32x4 (&acc)[2][2][4][2], const Unit& u, int wr, int wc, int fr, int fq) const {
        const int row0 = u.pm * 256 + wr * 64 + fr, c0 = u.pn * 256 + wc * 32 + 8 * fq;
        v4u old[2][4][2];
#pragma unroll
        for (int ai = 0; ai < 2; ++ai)
#pragma unroll
            for (int m = 0; m < 4; ++m)
#pragma unroll
                for (int bj = 0; bj < 2; ++bj) old[ai][m][bj] = *(const GAS v4u*)(d + (size_t)(row0 + ai * 128 + m * 16) * DM + c0 + 128 * bj);
#pragma unroll
        for (int ai = 0; ai < 2; ++ai) {
#pragma unroll
            for (int m = 0; m < 4; ++m) { bf16* rowp = d + (size_t)(row0 + ai * 128 + m * 16) * DM + c0;
#pragma unroll
                for (int bj = 0; bj < 2; ++bj) { const f32x4 a0 = acc[ai][bj][m][0] * sc, a1 = acc[ai][bj][m][1] * sc; const v4u o = old[ai][m][bj];
                    v4u w; w.x = cvtpk(a0[0] + bflo(o.x), a0[1] + bfhi(o.x)); w.y = cvtpk(a0[2] + bflo(o.y), a0[3] + bfhi(o.y)); w.z = cvtpk(a1[0] + bflo(o.z), a1[1] + bfhi(o.z)); w.w = cvtpk(a1[2] + bflo(o.w), a1[3] + bfhi(o.w));
                    *(GAS v4u*)(rowp + 128 * bj) = w; } } }
    }
};
__device__ __forceinline__ float swiglu1(float g, float l) {
    g = fminf(g, 7.0f); l = fminf(fmaxf(l, -7.0f), 7.0f);
    const float s = __builtin_amdgcn_rcpf(1.0f + __builtin_amdgcn_exp2f(-1.702f * LOG2E * g));
    return g * s * (l + 1.0f);
}
constexpr float SWC = -1.702f * LOG2E;
__device__ __forceinline__ float swiglu_c(float cg, float l) {
    cg = fmaxf(cg, 7.0f * SWC); l = fminf(fmaxf(l, -7.0f), 7.0f);
    const float s = __builtin_amdgcn_rcpf(1.0f + __builtin_amdgcn_exp2f(cg));
    return (cg * s) * fmaf(l, ACT8_SCALE / SWC, ACT8_SCALE / SWC);
}
__device__ __forceinline__ f32x2 swiglu_c2(f32x2 cg, f32x2 l) {
    cg = (f32x2){fmaxf(cg.x, 7.0f * SWC), fmaxf(cg.y, 7.0f * SWC)}; l = (f32x2){fminf(fmaxf(l.x, -7.0f), 7.0f), fminf(fmaxf(l.y, -7.0f), 7.0f)};
    const f32x2 d = (f32x2){__builtin_amdgcn_exp2f(cg.x), __builtin_amdgcn_exp2f(cg.y)} + (f32x2){1.0f, 1.0f};
    const f32x2 s = (f32x2){__builtin_amdgcn_rcpf(d.x), __builtin_amdgcn_rcpf(d.y)};
    constexpr float K = ACT8_SCALE / SWC;
    return (cg * s) * __builtin_elementwise_fma(l, (f32x2){K, K}, (f32x2){K, K});
}
__device__ __forceinline__ unsigned pack_fp8x4(float a, float b, float c, float d) { int w = 0; w = __builtin_amdgcn_cvt_pk_fp8_f32(a, b, w, false); w = __builtin_amdgcn_cvt_pk_fp8_f32(c, d, w, true); return (unsigned)w; }
struct EpiSwiglu {
    static constexpr bool PARK = true;
    unsigned char* act; const float* b1; const float* lrs; float sc;
    __device__ __forceinline__ void pre(const Unit& u, int wid, int lane, unsigned park) const {
        if (wid < 4) glds4((const GAS void*)(b1 + (size_t)u.e * 2048 + u.pn * 256 + 64 * wid + lane), park + 256u * (unsigned)wid);
        else glds4((const GAS void*)(lrs + (size_t)u.e * NTOK + u.lt * 256 + 64 * (wid - 4) + lane), park + 1024u + 256u * (unsigned)(wid - 4)); }
    __device__ __forceinline__ void operator()(const f32x4 (&acc)[2][2][4][2], const Unit& u, int wr, int wc, int fr, int fq, const LAS float* park) const {
        const int row0 = u.pm * 256 + wr * 64 + fr; const int c0 = u.pn * 256 + wc * 64 + 16 * fq;
        f32x4 bv[2][2];
#pragma unroll
        for (int bj = 0; bj < 2; ++bj)
#pragma unroll
            for (int n = 0; n < 2; ++n) bv[bj][n] = *(const LAS f32x4*)(park + wc * 64 + 16 * fq + 8 * bj + 4 * n) * (f32x4){SWC, 1.f, SWC, 1.f};
        float rsv[2][4];
        { const LAS float* rp = park + 256 + wr * 64 + fr;
#pragma unroll
          for (int ai = 0; ai < 2; ++ai)
#pragma unroll
              for (int m = 0; m < 4; ++m) rsv[ai][m] = sc * rp[ai * 128 + m * 16]; }
#pragma unroll
        for (int ai = 0; ai < 2; ++ai)
#pragma unroll
            for (int m = 0; m < 4; ++m) { unsigned char* rowp = act + (size_t)(row0 + ai * 128 + m * 16) * FF + (c0 >> 1);
                const float rs = rsv[ai][m]; const f32x2 rs2 = (f32x2){rs * SWC, rs};
                v2u w;
#pragma unroll
                for (int bj = 0; bj < 2; ++bj) { const f32x4 a0 = acc[ai][bj][m][0], a1 = acc[ai][bj][m][1]; const f32x4 b0 = bv[bj][0], b1_ = bv[bj][1];
                    const f32x2 p0 = __builtin_elementwise_fma((f32x2){a0[0], a0[1]}, rs2, (f32x2){b0[0], b0[1]}), p1 = __builtin_elementwise_fma((f32x2){a0[2], a0[3]}, rs2, (f32x2){b0[2], b0[3]});
                    const f32x2 p2 = __builtin_elementwise_fma((f32x2){a1[0], a1[1]}, rs2, (f32x2){b1_[0], b1_[1]}), p3 = __builtin_elementwise_fma((f32x2){a1[2], a1[3]}, rs2, (f32x2){b1_[2], b1_[3]});
                    const f32x2 o01 = swiglu_c2((f32x2){p0.x, p1.x}, (f32x2){p0.y, p1.y}), o23 = swiglu_c2((f32x2){p2.x, p3.x}, (f32x2){p2.y, p3.y});
                    const unsigned p = pack_fp8x4(o01.x, o01.y, o23.x, o23.y);
                    if (bj == 0) w.x = p; else w.y = p; }
                *(GAS v2u*)rowp = w; }
    }
};
struct EpiBias {
    static constexpr bool PARK = true;
    void* y; const float* b2; float sc;
    __device__ __forceinline__ void pre(const Unit& u, int wid, int lane, unsigned park) const {
        if (wid < 4) glds4((const GAS void*)(b2 + (size_t)u.e * 1024 + u.pn * 256 + 64 * wid + lane), park + 256u * (unsigned)wid); }
    __device__ __forceinline__ void operator()(const f32x4 (&acc)[2][2][4][2], const Unit& u, int wr, int wc, int fr, int fq, const LAS float* park) const {
        const int row0 = u.pm * 256 + wr * 64 + fr; const int c0 = u.pn * 256 + wc * 32 + 8 * fq;
        f32x4 bv[2][2];
#pragma unroll
        for (int bj = 0; bj < 2; ++bj)
#pragma unroll
            for (int n = 0; n < 2; ++n) bv[bj][n] = *(const LAS f32x4*)(park + wc * 32 + 8 * fq + bj * 128 + 4 * n) * (Y_FP8 ? Y8_SCALE : 1.0f);
        const float scy = sc * (Y_FP8 ? Y8_SCALE : 1.0f);
#pragma unroll
        for (int ai = 0; ai < 2; ++ai)
#pragma unroll
            for (int m = 0; m < 4; ++m) { const size_t ro = (size_t)(row0 + ai * 128 + m * 16) * DM + c0;
#pragma unroll
                for (int bj = 0; bj < 2; ++bj) { const f32x4 v0 = acc[ai][bj][m][0] * scy + bv[bj][0], v1 = acc[ai][bj][m][1] * scy + bv[bj][1];
                    if (Y_FP8) { v2u w; w.x = pack_fp8x4(v0[0], v0[1], v0[2], v0[3]); w.y = pack_fp8x4(v1[0], v1[1], v1[2], v1[3]);
                        *(GAS v2u*)((unsigned char*)y + ro + 128 * bj) = w; }
                    else { v4u w; w.x = cvtpk(v0[0], v0[1]); w.y = cvtpk(v0[2], v0[3]); w.z = cvtpk(v1[0], v1[1]); w.w = cvtpk(v1[2], v1[3]);
                        *(GAS v4u*)((bf16*)y + ro + 128 * bj) = w; } } }
    }
};
}

constexpr size_t MiB = 1u << 20;
constexpr size_t WS_CTL = 0, CTL_ZERO_BYTES = 1 * MiB;
constexpr size_t WS_WDI = 2 * MiB, WS_WDO = 14 * MiB, WS_WRI = 18 * MiB, WS_WRO = 42 * MiB, WS_W1 = 50 * MiB, WS_W2 = 562 * MiB;
constexpr size_t WS_HB = 818 * MiB;
constexpr size_t WS_PROJ = 946 * MiB;
constexpr size_t WS_AO = 1842 * MiB;
constexpr size_t WS_ROF = 1970 * MiB, WS_ROB = 2226 * MiB, WS_RGO = 2482 * MiB, WS_RP = 2738 * MiB;
constexpr size_t WS_ACT = 2754 * MiB, WS_Y = 3282 * MiB;
constexpr float H8U_SCALE = 4.0f;
constexpr float AO8_SCALE = 8.0f, WDO_SCALE = 128.0f;
constexpr float H8_SCALE = 8.0f, W1_SCALE = 64.0f, W2_SCALE = 128.0f, WRI_SCALE = 64.0f, WRO_SCALE = 128.0f, GO8_SCALE = 4.0f;
constexpr size_t WS_LIST = 3810 * MiB, WS_TSLOT = 3818 * MiB, WS_TGATE = 3819 * MiB, WS_HB8 = 3820 * MiB, WS_XB = 3884 * MiB, WS_WRT = 4012 * MiB, WS_LRS = 4013 * MiB, WS_END = 4021 * MiB;
constexpr int WRP = 1032;
constexpr int CW_BAR = 4096, CW_CNT = 8192;
constexpr int RING_BYTES = 147456, MISC_OFF = RING_BYTES, LDS_BYTES = 163840;

#define RLX_AGENT __ATOMIC_RELAXED, __HIP_MEMORY_SCOPE_AGENT
#define XB_TMO      128
#define XB_XCNT(j)  (256  + 64 * (j))
#define XB_XSUB(j)  (1280 + 64 * (j))
#define XB_XGEN(j)  (2304 + 64 * (j))
#define XB_TOP      3328
#define XB_TOPGEN   3392
#define XCD_BAR_WORDS 3456
#define XB_SPIN_CAP (1u << 18)

__device__ __forceinline__ unsigned xb_ld(unsigned* p)              { return __hip_atomic_load(p, __ATOMIC_RELAXED, __HIP_MEMORY_SCOPE_AGENT); }
__device__ __forceinline__ unsigned xb_add(unsigned* p, unsigned v) { return __hip_atomic_fetch_add(p, v, __ATOMIC_RELAXED, __HIP_MEMORY_SCOPE_AGENT); }
__device__ __forceinline__ unsigned xb_xcc_id() { return (unsigned)__builtin_amdgcn_s_getreg((3 << 11) | 20) & 0xFu; }
#define XB_SPIN(cond, bar) do { unsigned _sp = 0; while (cond) { __builtin_amdgcn_s_sleep(1); \
    if ((++_sp & 255u) == 0u) { if (xb_ld(&(bar)[XB_TMO])) break; if (_sp > XB_SPIN_CAP) { atomicAdd(&(bar)[XB_TMO], 1u); break; } } } } while (0)

struct XcdBarrier {
    unsigned* bar; unsigned x;
    volatile LAS unsigned* st;
};

__device__ __forceinline__ XcdBarrier xcd_barrier_post(unsigned* bar, volatile LAS unsigned* st) {
    XcdBarrier b; b.bar = bar; b.x = xb_xcc_id(); b.st = st;
    if (opaque_tid() == 0) (void)xb_add(&bar[XB_XCNT(b.x)], 1u);
    return b;
}
__device__ __forceinline__ void xcd_barrier_complete(unsigned* bar, unsigned x, unsigned& nloc, unsigned& nx) {
    const unsigned G = gridDim.x * gridDim.y * gridDim.z;
    unsigned sum, cnt, mine, sp = 0u;
    for (;;) {
        sum = 0u; cnt = 0u; mine = 0u;
#pragma unroll
        for (unsigned j = 0; j < 16; ++j) { const unsigned c = xb_ld(&bar[XB_XCNT(j)]); sum += c; cnt += (c > 0u) ? 1u : 0u; mine = (j == x) ? c : mine; }
        if (sum == G) break;
        __builtin_amdgcn_s_sleep(1);
        if ((++sp & 255u) == 0u) { if (xb_ld(&bar[XB_TMO])) break; if (sp > XB_SPIN_CAP) { atomicAdd(&bar[XB_TMO], 1u); break; } }
    }
    nloc = mine > 0u ? mine : 1u; nx = cnt > 0u ? cnt : 1u;
}

__device__ __forceinline__ void xcd_barrier(const XcdBarrier& b) {
    asm volatile("s_waitcnt vmcnt(0)" ::: "memory");
    __syncthreads();
    if (opaque_tid() == 0) {
        unsigned* bar = b.bar;
        __builtin_amdgcn_s_waitcnt(0);
        unsigned nloc = b.st[0], nx = b.st[1];
        if (nloc == 0u) { xcd_barrier_complete(bar, b.x, nloc, nx); b.st[0] = nloc; b.st[1] = nx; }
        const unsigned old = xb_add(&bar[XB_XSUB(b.x)], 1u);
        const unsigned gen = old / nloc;
        if (old + 1u == (gen + 1u) * nloc) {
            __builtin_amdgcn_fence(__ATOMIC_RELEASE, "agent");
            asm volatile("s_waitcnt vmcnt(0)" ::: "memory");
            const unsigned og = xb_add(&bar[XB_TOP], 1u);
            const unsigned tg = og / nx;
            if (og + 1u == (tg + 1u) * nx) xb_add(&bar[XB_TOPGEN], 1u);
            else XB_SPIN(xb_ld(&bar[XB_TOPGEN]) == tg, bar);
            __builtin_amdgcn_fence(__ATOMIC_ACQUIRE, "agent");
            xb_add(&bar[XB_XGEN(b.x)], 1u);
            asm volatile("s_waitcnt vmcnt(0)" ::: "memory");
        } else {
            XB_SPIN(xb_ld(&bar[XB_XGEN(b.x)]) == gen, bar);
            __builtin_amdgcn_fence(__ATOMIC_ACQUIRE, "agent");
            asm volatile("s_waitcnt vmcnt(0)" ::: "memory");
        }
    }
    __syncthreads();
}

#ifndef ATT_OUT_FP8
#define ATT_OUT_FP8 1
#endif
namespace att {
typedef short v4i16_t __attribute__((ext_vector_type(4)));
constexpr int KSLOT = 8192, VSLOT = 16384;
constexpr int NSLOT = 3;
constexpr int L_K = 0, L_V = NSLOT * KSLOT, L_WS = L_V + NSLOT * VSLOT, L_OST = L_WS + 8 * 512, L_END = L_OST + 8 * 8192;
__device__ __forceinline__ int crow(int r, int hi) { return (r & 3) + 8 * (r >> 2) + 4 * hi; }
__device__ __forceinline__ s16x4 vtr(const LAS char* p) { return __builtin_bit_cast(s16x4, __builtin_amdgcn_ds_read_tr16_b64_v4i16((LAS v4i16_t*)p)); }
__device__ __forceinline__ bf16x8 cat8(s16x4 lo, s16x4 hi) { return (bf16x8){lo[0], lo[1], lo[2], lo[3], hi[0], hi[1], hi[2], hi[3]}; }
__device__ __forceinline__ bf16x8 pack8(const f32x16& p, int s) {
    v4u w; w.x = cvtpk(p[8 * s], p[8 * s + 1]); w.y = cvtpk(p[8 * s + 2], p[8 * s + 3]); w.z = cvtpk(p[8 * s + 4], p[8 * s + 5]); w.w = cvtpk(p[8 * s + 6], p[8 * s + 7]);
    return __builtin_bit_cast(bf16x8, w);
}
__device__ __forceinline__ void glds16(const GAS void* gsrc, unsigned lds_dst) { unsigned keep;
    asm volatile("s_mov_b32 %0, m0\n\ts_mov_b32 m0, %2\n\ts_nop 0\n\tglobal_load_lds_dwordx4 %1, off\n\ts_mov_b32 m0, %0" : "=&s"(keep) : "v"(gsrc), "s"(lds_dst) : "memory"); }
struct AttnArgs { const bf16* Q; const bf16* K; const bf16* V; bf16* O; float lam; const float* subg; float oscale; float qkb; };

__device__ __forceinline__ int tile_seq(int it, int q4, int nl) { return it < 4 ? q4 + it : (it < 4 + nl ? q4 + 3 - it : q4 + it - nl); }

__device__ __forceinline__ void attn_unit(int b, int h, int qb, const AttnArgs& A, LAS char* shm) {
    const int tid = opaque_tid(), lane = tid & 63, r32 = lane & 31, hi = lane >> 5; const int wid = __builtin_amdgcn_readfirstlane(tid >> 6);
    const size_t rowbase = (size_t)b * SEQ;
    const int qw0 = qb * 256 + wid * 32, q4 = qb * 4, qh = qw0 >> 5;
    const float fi = (float)(qw0 + r32);
    const float slope = __builtin_amdgcn_exp2f(-(float)(h + 1)), sl2 = slope * LOG2E;
    constexpr float SKIP_T = 32.0f;
    const int W = (int)fminf((2.0f * A.qkb + SKIP_T) / slope, 8192.0f) + 1;
    const int jlo = max(0, (qb * 256 - W) >> 6), jhi = min(SEQ / 64 - 1, (qb * 256 + 255 + W) >> 6);
    const int NT = jhi - jlo + 1, nl = qb * 4 - jlo;
    const float B2 = A.qkb * LOG2E; const bool fixref = (2.0f * B2 < 100.0f);
    const bf16x8 ones = (bf16x8){0x3F80, 0x3F80, 0x3F80, 0x3F80, 0x3F80, 0x3F80, 0x3F80, 0x3F80};
    const float sl2h = sl2 * (float)(4 * hi);
    LAS float* wsf = (LAS float*)(shm + L_WS) + wid * 128;
#pragma unroll 1
    for (int c = 0; c < 2; ++c) {
        bf16x8 qr[4];
        { const bf16* qu = A.Q + (rowbase + qw0) * DM + h * 128 + c * 64; const unsigned ql = (unsigned)(r32 * DM + hi * 8);
#pragma unroll
          for (int d0 = 0; d0 < 4; ++d0) qr[d0] = __builtin_nontemporal_load((const GAS bf16x8*)(qu + (ql + d0 * 16)));
#pragma unroll
          for (int d0 = 0; d0 < 4; ++d0) asm volatile("" : "+v"(qr[d0])); }
        float m = fixref ? B2 : 0.f; f32x16 o[4], ol;
#pragma unroll
        for (int r = 0; r < 16; ++r) ol[r] = 0.f;
#pragma unroll
        for (int d0 = 0; d0 < 4; ++d0)
#pragma unroll
            for (int r = 0; r < 16; ++r) o[d0][r] = 0.f;
        const bf16* kgu = A.K + rowbase * DM + h * 128 + c * 64 + wid * 8;
        const bf16* vgu = A.V + (rowbase + 16 * (wid & 3)) * DM + h * 128 + 32 * (wid >> 2);
        const unsigned kl = (unsigned)(lane * DM), vl = (unsigned)((lane >> 2) * DM + 8 * (lane & 3));
        const unsigned lds0 = (unsigned)(size_t)shm;
        const unsigned kw = lds0 + L_K + wid * 1024, vw = lds0 + L_V + wid * 1024;
#define ATT_DMA(tile, slot) do { const size_t to_ = (size_t)(tile) * 64 * DM; \
            glds16((const GAS void*)(kgu + to_ + kl), (unsigned)__builtin_amdgcn_readfirstlane(kw + (slot) * KSLOT)); \
            glds16((const GAS void*)(vgu + to_ + vl), (unsigned)__builtin_amdgcn_readfirstlane(vw + (slot) * VSLOT)); \
            glds16((const GAS void*)(vgu + to_ + 64 + vl), (unsigned)__builtin_amdgcn_readfirstlane(vw + (slot) * VSLOT + 8192)); } while (0)
        ATT_DMA(tile_seq(0, q4, nl), 0); ATT_DMA(tile_seq(1, q4, nl), 1);
        asm volatile("s_waitcnt vmcnt(0)\n\ts_barrier" ::: "memory");
        int slot = 0;
#define ATT_QK(PN, jt, hb_, sl_) do { const int kh_ = 2 * (jt) + (hb_); const LAS char* kb_ = shm + L_K + (sl_) * KSLOT + hi * 1024 + r32 * 16 + (hb_) * 512; \
            bf16x8 kf_[4]; _Pragma("unroll") for (int d0 = 0; d0 < 4; ++d0) kf_[d0] = *(const LAS bf16x8*)(kb_ + d0 * 2048); \
            if (kh_ == qh) { const float x0 = (float)(32 * kh_) - fi + (float)(4 * hi); \
                _Pragma("unroll") for (int r = 0; r < 16; ++r) { const float x = x0 + (float)((r & 3) + 8 * (r >> 2)); PN[r] = -sl2 * fabsf(x) - m; } \
            } else if (kh_ < qh) { const float base = sl2 * ((float)(32 * kh_) - fi) - m + sl2h; \
                _Pragma("unroll") for (int r = 0; r < 16; ++r) PN[r] = fmaf(sl2, (float)((r & 3) + 8 * (r >> 2)), base); \
            } else { const float base = sl2 * (fi - (float)(32 * kh_)) - m - sl2h; \
                _Pragma("unroll") for (int r = 0; r < 16; ++r) PN[r] = fmaf(-sl2, (float)((r & 3) + 8 * (r >> 2)), base); } \
            __builtin_amdgcn_sched_barrier(0); \
            _Pragma("unroll") for (int d0 = 0; d0 < 4; ++d0) PN = __builtin_amdgcn_mfma_f32_32x32x16_bf16(kf_[d0], qr[d0], PN, 0, 0, 0); \
            __builtin_amdgcn_sched_barrier(0); } while (0)
        f32x16 pn;
#if defined(ATT_DUP) && (ATT_DUP & 8)
        bf16x8 zfrag_ = (bf16x8){0, 0, 0, 0, 0, 0, 0, 0}; asm volatile("" : "+v"(zfrag_));
#endif
        ATT_QK(pn, tile_seq(0, q4, nl), 0, 0);
#pragma unroll 1
        for (int it = 0; it < NT; ++it) {
            const int j = tile_seq(it, q4, nl), buf = slot, nslot = slot == NSLOT - 1 ? 0 : slot + 1;
            if (it + 2 < NT) { const int s2 = slot >= 1 ? slot - 1 : slot + 2; ATT_DMA(tile_seq(it + 2, q4, nl), s2);
#if defined(ATT_DUP) && (ATT_DUP & 2)
                ATT_DMA(tile_seq(it + 2, q4, nl), s2);
#endif
            }
            const LAS char* vp = shm + L_V + buf * VSLOT + ((lane >> 4) & 1) * 32 + (lane & 3) * 8 + (4 * hi + ((lane & 15) >> 2)) * 64;
#pragma unroll
            for (int hb = 0; hb < 2; ++hb) {
                f32x16 p = pn;
                if (hb == 0) ATT_QK(pn, j, 1, buf);
                else if (it + 1 < NT) ATT_QK(pn, tile_seq(it + 1, q4, nl), 0, nslot);
                s16x4 vk0[8], vk1[8];
#define ATT_VLDK(dst, ks) do { _Pragma("unroll") for (int d0 = 0; d0 < 4; ++d0) { dst[2 * d0] = vtr(vp + d0 * 4096 + (2 * hb + (ks)) * 1024); dst[2 * d0 + 1] = vtr(vp + d0 * 4096 + (2 * hb + (ks)) * 1024 + 512); } } while (0)
                ATT_VLDK(vk0, 0);
                __builtin_amdgcn_sched_barrier(0);
                if (!fixref) {
                    float rm = fmaxf(p[0], p[1]);
#pragma unroll
                    for (int r = 2; r < 16; ++r) rm = fmaxf(rm, p[r]);
                    rm = fmaxf(rm, shfl_xor_(rm, 32, lane_now()));
                    const bool first = (it == 0 && hb == 0);
                    if (first || __any(rm > 6.0f)) {
                        const float dl = first ? rm : fmaxf(rm, 0.f);
                        m += dl;
#pragma unroll
                        for (int r = 0; r < 16; ++r) { p[r] -= dl; pn[r] -= dl; }
                        if (!first) {
                            const float f = __builtin_amdgcn_exp2f(-dl);
                            if (hi == 0) wsf[r32] = f;
#pragma unroll
                            for (int g = 0; g < 4; ++g) { const f32x4 t = *(const LAS f32x4*)(wsf + 8 * g + 4 * hi);
                                ol[4 * g] *= t[0]; ol[4 * g + 1] *= t[1]; ol[4 * g + 2] *= t[2]; ol[4 * g + 3] *= t[3];
#pragma unroll
                                for (int d0 = 0; d0 < 4; ++d0) { o[d0][4 * g] *= t[0]; o[d0][4 * g + 1] *= t[1]; o[d0][4 * g + 2] *= t[2]; o[d0][4 * g + 3] *= t[3]; } }
                        }
                    }
                }
#define EX2(i) do { p[i] = __builtin_amdgcn_exp2f(p[i]); p[(i) + 1] = __builtin_amdgcn_exp2f(p[(i) + 1]); } while (0)
#define SB() __builtin_amdgcn_sched_barrier(0)
#pragma unroll
                for (int r = 0; r < 8; ++r) p[r] = __builtin_amdgcn_exp2f(p[r]);
                const bf16x8 pw0 = pack8(p, 0);
                SB();
                ATT_VLDK(vk1, 1);
                SB();
                __builtin_amdgcn_s_setprio(1);
                ol = __builtin_amdgcn_mfma_f32_32x32x16_bf16(pw0, ones, ol, 0, 0, 0); EX2(8); SB();
                o[0] = __builtin_amdgcn_mfma_f32_32x32x16_bf16(pw0, cat8(vk0[0], vk0[1]), o[0], 0, 0, 0); EX2(10); SB();
                o[1] = __builtin_amdgcn_mfma_f32_32x32x16_bf16(pw0, cat8(vk0[2], vk0[3]), o[1], 0, 0, 0); EX2(12); SB();
                o[2] = __builtin_amdgcn_mfma_f32_32x32x16_bf16(pw0, cat8(vk0[4], vk0[5]), o[2], 0, 0, 0); EX2(14); SB();
                o[3] = __builtin_amdgcn_mfma_f32_32x32x16_bf16(pw0, cat8(vk0[6], vk0[7]), o[3], 0, 0, 0);
                const bf16x8 pw1 = pack8(p, 1);
                SB();
                ol = __builtin_amdgcn_mfma_f32_32x32x16_bf16(pw1, ones, ol, 0, 0, 0);
#pragma unroll
                for (int d0 = 0; d0 < 4; ++d0) o[d0] = __builtin_amdgcn_mfma_f32_32x32x16_bf16(pw1, cat8(vk1[2 * d0], vk1[2 * d0 + 1]), o[d0], 0, 0, 0);
                __builtin_amdgcn_s_setprio(0);
                SB();
#undef EX2
#undef SB
#undef ATT_VLDK
            }
            asm volatile("s_waitcnt vmcnt(0) lgkmcnt(0)\n\ts_barrier" ::: "memory");
            slot = nslot;
        }
#undef ATT_QK
#undef ATT_DMA
        int le = lane; asm volatile("" : "+v"(le));
        const int r32e = le & 31, hie = le >> 5;
        float rl[16];
#pragma unroll
        for (int r = 0; r < 16; ++r) rl[r] = __builtin_amdgcn_rcpf(ol[r]);
        LAS unsigned* svl = (LAS unsigned*)(shm + L_OST + wid * 8192) + le;
        if (c == 0) {
#pragma unroll
            for (int d0 = 0; d0 < 4; ++d0)
#pragma unroll
                for (int r2 = 0; r2 < 8; ++r2) svl[(d0 * 8 + r2) * 64] = cvtpk(o[d0][2 * r2] * rl[2 * r2], o[d0][2 * r2 + 1] * rl[2 * r2 + 1]);
        } else {
            float ss[16];
#pragma unroll
            for (int r = 0; r < 16; ++r) ss[r] = 0.f;
#pragma unroll
            for (int d0 = 0; d0 < 4; ++d0)
#pragma unroll
                for (int r2 = 0; r2 < 8; ++r2) { const unsigned svv = svl[(d0 * 8 + r2) * 64];
                    const float a = bflo(svv) - A.lam * o[d0][2 * r2] * rl[2 * r2], bq = bfhi(svv) - A.lam * o[d0][2 * r2 + 1] * rl[2 * r2 + 1];
                    o[d0][2 * r2] = a; o[d0][2 * r2 + 1] = bq; ss[2 * r2] += a * a; ss[2 * r2 + 1] += bq * bq; }
#pragma unroll
            for (int x = 1; x < 32; x <<= 1) { const int pa = (le ^ x) << 2;
#pragma unroll
                for (int r = 0; r < 16; ++r) ss[r] += __uint_as_float(__builtin_amdgcn_ds_bpermute(pa, __float_as_uint(ss[r]))); }
#pragma unroll
            for (int r = 0; r < 16; ++r) ss[r] = __builtin_amdgcn_rsqf(ss[r] * (1.0f / 128.0f) + NORM_EPS);
            asm volatile("s_waitcnt lgkmcnt(0)" ::: "memory");
#if ATT_OUT_FP8
            LAS unsigned char* stg = (LAS unsigned char*)(shm + L_OST + wid * 8192);
#pragma unroll
            for (int d0 = 0; d0 < 4; ++d0) { const float sg = ((const GAS float*)A.subg)[r32e + 32 * d0] * A.oscale * AO8_SCALE;
#pragma unroll
                for (int r = 0; r < 16; ++r) { const float v_ = o[d0][r] * ss[r] * sg; stg[crow(r, hie) * 128 + d0 * 32 + r32e] = (unsigned char)(__builtin_amdgcn_cvt_pk_fp8_f32(v_, v_, 0, false) & 0xff); } }
            unsigned char* Ow = (unsigned char*)A.O + (rowbase + qw0) * DM + h * 128; const unsigned olo = (unsigned)((le >> 3) * DM + (le & 7) * 16);
#pragma unroll
            for (int i = 0; i < 4; ++i) { const int row = i * 8 + (le >> 3), ch = le & 7; const v4u v = *(const LAS v4u*)(stg + row * 128 + ch * 16); *(GAS v4u*)(Ow + (olo + (unsigned)(i * 8 * DM))) = v; }
#else
            LAS bf16* stg = (LAS bf16*)(shm + L_OST + wid * 8192);
#pragma unroll
            for (int d0 = 0; d0 < 4; ++d0) { const float sg = ((const GAS float*)A.subg)[r32e + 32 * d0] * A.oscale;
#pragma unroll
                for (int r = 0; r < 16; ++r) stg[crow(r, hie) * 128 + d0 * 32 + r32e] = (bf16)(cvtpk(o[d0][r] * ss[r] * sg, 0.f) & 0xffffu); }
            bf16* Ow = A.O + (rowbase + qw0) * DM + h * 128; const unsigned olo = (unsigned)((le >> 4) * DM + (le & 15) * 8);
#pragma unroll
            for (int i = 0; i < 8; ++i) { const int row = i * 4 + (le >> 4), ch = le & 15; const v4u v = *(const LAS v4u*)(stg + row * 128 + ch * 8); *(GAS v4u*)(Ow + (olo + (unsigned)(i * 4 * DM))) = v; }
#endif
        }
    }
}
}

namespace ret {
using att::crow; using att::vtr; using att::cat8; using att::pack8;
constexpr int QPITCH = 520, PPITCH = 72;
constexpr int L_Q = 0, L_KT = 32 * QPITCH, L_VT = L_KT + 16384, L_PT = L_VT + 16384, BUFB = L_PT + 32 * PPITCH;

__device__ __forceinline__ void rp_unit(int b, int h, int sc, const bf16* RQ, const bf16* RKF, const bf16* RKB, bf16* RP, float lgf, float lgb) {
    const int lane = opaque_tid() & 63, r32 = lane & 31, hi = lane >> 5;
    const size_t tb = (size_t)b * SEQ + 32 * sc;
    const size_t ro = (tb + r32) * 1024 + h * 256 + 8 * hi;
    f32x16 pf;
#pragma unroll
    for (int r = 0; r < 16; ++r) pf[r] = 0.f;
#pragma unroll
    for (int ks = 0; ks < 16; ++ks) {
        const bf16x8 a = *(const GAS bf16x8*)(RQ + ro + 16 * ks), kf = *(const GAS bf16x8*)(RKF + ro + 16 * ks);
        pf = __builtin_amdgcn_mfma_f32_32x32x16_bf16(a, kf, pf, 0, 0, 0);
    }
    const float fj = (float)r32, upj = lgf * (fj - 31.0f) + lgb * fj;
#pragma unroll
    for (int r = 0; r < 16; ++r) { const int i = crow(r, hi); const float fi = (float)i;
        const float v = pf[r] * __expf((r32 <= i) ? lgf * (fi - 31.0f) : upj - lgb * fi);
        ((GAS bf16*)RP)[(tb + i) * 128 + h * 32 + r32] = (bf16)(cvtpk(v, 0.f) & 0xffffu); }
}

struct ChainArgs { const bf16* RQ; const bf16* RK; const bf16* RV; const bf16* RP; bf16* OUT; float lg; };

__device__ __forceinline__ void chain_unit(int b, int h, int dir, int vs, const ChainArgs& A, LAS char* shm) {
    const int tid = opaque_tid(), lane = tid & 63, r32 = lane & 31, hi = lane >> 5; const int wid = __builtin_amdgcn_readfirstlane(tid >> 6);
    const float decay = __expf(A.lg * 32.0f);
    const float xiB = __expf(A.lg * (dir == 0 ? (float)(4 * hi + 1) : (float)(32 - 4 * hi))), xiU = __expf(dir == 0 ? A.lg : -A.lg), xiW = __expf(dir == 0 ? 8.0f * A.lg : -8.0f * A.lg);
    f32x16 S[8];
#pragma unroll
    for (int db = 0; db < 8; ++db)
#pragma unroll
        for (int r = 0; r < 16; ++r) S[db][r] = 0.f;
    const int qrow = tid >> 4, qch = tid & 15;
    const bf16* qg = A.RQ + ((size_t)b * SEQ + qrow) * 1024 + h * 256 + qch * 8;
    const int srow = lane >> 2, sch = lane & 3;
    const bf16* kg = A.RK + ((size_t)b * SEQ + 16 * (wid & 1) + srow) * 1024 + h * 256 + 32 * (wid >> 1) + 8 * sch;
    const bf16* vg = A.RV + ((size_t)b * SEQ + 16 * (wid & 1) + srow) * 2048 + h * 512 + vs * 256 + 32 * (wid >> 1) + 8 * sch;
    const bf16* pg = A.RP + ((size_t)b * SEQ + (tid >> 2)) * 128 + h * 32 + (tid & 3) * 8;
    v4u q0, q1, k0, k1, v0, v1, pp;
    pp = (v4u){0u, 0u, 0u, 0u};
#define RET_LOAD(sc) do { const size_t t_ = (size_t)(sc) * 32; \
        q0 = *(const GAS v4u*)(qg + t_ * 1024); q1 = *(const GAS v4u*)(qg + t_ * 1024 + 128); \
        k0 = *(const GAS v4u*)(kg + t_ * 1024); k1 = *(const GAS v4u*)(kg + t_ * 1024 + 128); \
        v0 = __builtin_nontemporal_load((const GAS v4u*)(vg + t_ * 2048)); v1 = __builtin_nontemporal_load((const GAS v4u*)(vg + t_ * 2048 + 128)); \
        if (dir == 0 && tid < 128) pp = *(const GAS v4u*)(pg + t_ * 128); } while (0)
#define RET_STORE(bufp) do { LAS char* b_ = (bufp); \
        *(LAS v2u*)(b_ + L_Q + qrow * QPITCH + qch * 16) = (v2u){q0.x, q0.y}; *(LAS v2u*)(b_ + L_Q + qrow * QPITCH + qch * 16 + 8) = (v2u){q0.z, q0.w}; \
        *(LAS v2u*)(b_ + L_Q + qrow * QPITCH + qch * 16 + 256) = (v2u){q1.x, q1.y}; *(LAS v2u*)(b_ + L_Q + qrow * QPITCH + qch * 16 + 264) = (v2u){q1.z, q1.w}; \
        *(LAS v4u*)(b_ + L_KT + wid * 1024 + lane * 16) = k0; *(LAS v4u*)(b_ + L_KT + (wid + 8) * 1024 + lane * 16) = k1; \
        *(LAS v4u*)(b_ + L_VT + wid * 1024 + lane * 16) = v0; *(LAS v4u*)(b_ + L_VT + (wid + 8) * 1024 + lane * 16) = v1; \
        if (dir == 0 && tid < 128) { *(LAS v2u*)(b_ + L_PT + (tid >> 2) * PPITCH + (tid & 3) * 16) = (v2u){pp.x, pp.y}; *(LAS v2u*)(b_ + L_PT + (tid >> 2) * PPITCH + (tid & 3) * 16 + 8) = (v2u){pp.z, pp.w}; } } while (0)
    RET_LOAD(dir == 0 ? 0 : 127);
    RET_STORE(shm);
    __syncthreads();
    const int tro = ((lane >> 4) & 1) * 32 + (lane & 3) * 8 + (4 * hi + ((lane & 15) >> 2)) * 64;
#pragma unroll 1
    for (int s = 0; s < 128; ++s) {
        const int sc = dir == 0 ? s : 127 - s;
        LAS char* buf = shm + (s & 1) * BUFB;
        if (s + 1 < 128) RET_LOAD(dir == 0 ? s + 1 : 126 - s);
        f32x16 out;
#pragma unroll
        for (int r = 0; r < 16; ++r) out[r] = 0.f;
        const LAS char* qb = buf + L_Q + r32 * QPITCH + 8 * hi;
#pragma unroll
        for (int db = 0; db < 8; ++db)
#pragma unroll
            for (int s2 = 0; s2 < 2; ++s2) {
                const bf16x8 sb = pack8(S[db], s2);
                const bf16x8 a = cat8(*(const LAS s16x4*)(qb + (32 * db + 16 * s2) * 2), *(const LAS s16x4*)(qb + (32 * db + 16 * s2) * 2 + 16));
                out = __builtin_amdgcn_mfma_f32_32x32x16_bf16(a, sb, out, 0, 0, 0);
            }
        { float f8 = xiB;
#pragma unroll
          for (int g4 = 0; g4 < 4; ++g4) { float fz = f8;
#pragma unroll
              for (int z = 0; z < 4; ++z) { out[4 * g4 + z] *= fz; fz *= xiU; }
              f8 *= xiW; } }
        bf16x8 vf[2];
#pragma unroll
        for (int ks = 0; ks < 2; ++ks) vf[ks] = cat8(vtr(buf + L_VT + wid * 2048 + ks * 1024 + tro), vtr(buf + L_VT + wid * 2048 + ks * 1024 + 512 + tro));
        if (dir == 0) {
            const LAS char* pb = buf + L_PT + r32 * PPITCH + 8 * hi;
#pragma unroll
            for (int ks = 0; ks < 2; ++ks) {
                const bf16x8 a = cat8(*(const LAS s16x4*)(pb + 32 * ks), *(const LAS s16x4*)(pb + 32 * ks + 16));
                out = __builtin_amdgcn_mfma_f32_32x32x16_bf16(a, vf[ks], out, 0, 0, 0);
            }
        }
        { bf16* op = A.OUT + ((size_t)b * SEQ + (size_t)sc * 32) * 2048 + h * 512 + vs * 256 + 32 * wid + r32;
#pragma unroll
          for (int r = 0; r < 16; ++r) ((GAS bf16*)op)[(size_t)crow(r, hi) * 2048] = (bf16)(cvtpk(out[r], 0.f) & 0xffffu); }
#pragma unroll
        for (int db = 0; db < 8; ++db) {
#pragma unroll
            for (int r = 0; r < 16; ++r) S[db][r] *= decay;
#pragma unroll
            for (int ks = 0; ks < 2; ++ks) {
                const bf16x8 a = cat8(vtr(buf + L_KT + db * 2048 + ks * 1024 + tro), vtr(buf + L_KT + db * 2048 + ks * 1024 + 512 + tro));
                S[db] = __builtin_amdgcn_mfma_f32_32x32x16_bf16(a, vf[ks], S[db], 0, 0, 0);
            }
        }
        if (s + 1 < 128) RET_STORE(shm + ((s + 1) & 1) * BUFB);
        __syncthreads();
    }
#undef RET_LOAD
#undef RET_STORE
}
}

struct Args {
    const float* x; const float* diff_norm; const float* diff_w_in; const float* diff_w_out;
    const float* lq1; const float* lk1; const float* lq2; const float* lk2; const float* qn; const float* kn; const float* subln;
    const float* ret_norm; const float* ret_w_in; const float* ret_w_out; const float* lgf; const float* lgb;
    const float* moe_norm; const float* moe_rw; const float* moe_rb; const float* moe_w1; const float* moe_b1; const float* moe_w2; const float* moe_b2;
    float* out; unsigned char* ws; int ph_lo, ph_hi;
};
struct Frame {
    LAS unsigned char* lds; LAS int* misc;
    int tid, lane, wave, vcu, G;
};
constexpr int MI_TOFF = 16, MI_LCNT = 80, MI_LBASE = 112, MI_WSCR = 256, MI_STR = 768, MI_STEP = 1024, MI_STG = 2048;

__device__ __forceinline__ void load_row(const float* xrow, int lane, f32x4 (&v)[4]) {
    const GAS f32x4* p = (const GAS f32x4*)xrow + lane;
#pragma unroll
    for (int j = 0; j < 4; ++j) v[j] = p[64 * j];
}
__device__ __forceinline__ void rms_row(const f32x4 (&v)[4], const f32x4 (&g)[4], f32x4 (&h)[4]) {
    float s = 0.f;
#pragma unroll
    for (int j = 0; j < 4; ++j) s += (v[j][0] * v[j][0] + v[j][1] * v[j][1]) + (v[j][2] * v[j][2] + v[j][3] * v[j][3]);
    const float rstd = 1.0f / sqrtf(wave_sum(s) * (1.0f / DM) + NORM_EPS);
#pragma unroll
    for (int j = 0; j < 4; ++j) h[j] = v[j] * rstd * g[j];
}
__device__ __forceinline__ void store_row_bf16(bf16* hrow, int lane, const f32x4 (&h)[4]) {
    GAS v2u* o = (GAS v2u*)hrow + lane;
#pragma unroll
    for (int j = 0; j < 4; ++j) { v2u w; w.x = cvtpk(h[j][0], h[j][1]); w.y = cvtpk(h[j][2], h[j][3]); o[64 * j] = w; }
}

__device__ __forceinline__ void transpose_item(const float* W, int K, int N, bf16* WT, LAS float* scr, int item, int lane) {
    const int nblk = N / 32, kb = item / nblk, nb = item % nblk, k0 = 64 * kb, n0 = 32 * nb;
#pragma unroll 8
    for (int i = 0; i < 32; ++i) { const int kk = 2 * i + (lane >> 5); scr[kk * 33 + (lane & 31)] = ((const GAS float*)W)[(size_t)(k0 + kk) * N + n0 + (lane & 31)]; }
    asm volatile("s_waitcnt lgkmcnt(0)" ::: "memory");
    const int c = lane & 7;
#pragma unroll
    for (int j = 0; j < 4; ++j) { const int n = (lane >> 3) + 8 * j; const LAS float* s = scr + (8 * c) * 33 + n;
        v4u o; o.x = cvtpk(s[0 * 33], s[1 * 33]); o.y = cvtpk(s[2 * 33], s[3 * 33]); o.z = cvtpk(s[4 * 33], s[5 * 33]); o.w = cvtpk(s[6 * 33], s[7 * 33]);
        *(GAS v4u*)(WT + (size_t)(n0 + n) * K + k0 + 8 * c) = o; }
    asm volatile("s_waitcnt lgkmcnt(0)" ::: "memory");
}
#ifndef QKV_FP8
#define QKV_FP8 0
#endif
#ifndef DO_FP8
#define DO_FP8 1
#endif
#ifndef RO_FP8
#define RO_FP8 1
#endif
#ifndef RET_FP8
#define RET_FP8 1
#endif
__device__ __forceinline__ void transpose_item_fp8(const float* W, int K, int N, unsigned char* WT, float scale, LAS float* scr, int item, int lane) {
    const int nblk = N / 32, kb = item / nblk, nb = item % nblk, k0 = 64 * kb, n0 = 32 * nb;
#pragma unroll 8
    for (int i = 0; i < 32; ++i) { const int kk = 2 * i + (lane >> 5); scr[kk * 33 + (lane & 31)] = ((const GAS float*)W)[(size_t)(k0 + kk) * N + n0 + (lane & 31)]; }
    asm volatile("s_waitcnt lgkmcnt(0)" ::: "memory");
    const int n = lane >> 1, kh = lane & 1; const LAS float* s = scr + (32 * kh) * 33 + n;
    v4u o[2];
#pragma unroll
    for (int q = 0; q < 2; ++q) { unsigned w[4];
#pragma unroll
        for (int z = 0; z < 4; ++z) { const LAS float* t = s + (16 * q + 4 * z) * 33; w[z] = pg8::pack_fp8x4(t[0] * scale, t[33] * scale, t[66] * scale, t[99] * scale); }
        o[q] = (v4u){w[0], w[1], w[2], w[3]}; }
    unsigned char* dst = WT + (size_t)(n0 + n) * K + k0 + 32 * kh;
    *(GAS v4u*)dst = o[0]; *(GAS v4u*)(dst + 16) = o[1];
    asm volatile("s_waitcnt lgkmcnt(0)" ::: "memory");
}
__device__ __forceinline__ Frame relaunder(const Frame& F0) { Frame F = F0; F.tid = opaque_tid(); F.lane = F.tid & 63; F.wave = __builtin_amdgcn_readfirstlane(F.tid >> 6); return F; }
struct ConvItem { const float* W; unsigned char* WT; int K, N, k0, n0; float scale; };
__device__ __forceinline__ ConvItem conv_decode(const Args& a, int r) {
    constexpr int I2 = 2 * 16 * 192, I3 = 2 * 32 * 32, I4 = 128 * 16 * 64;
    ConvItem c; int per, nblk;
    if (r < I2) { per = 16 * 192; const int mi = r / per; c.W = a.ret_w_in + (size_t)mi * 1024 * 6144; c.WT = a.ws + WS_WRI + (size_t)mi * 6144 * 1024; c.K = 1024; c.N = 6144; c.scale = WRI_SCALE; r -= mi * per; }
    else if ((r -= I2) < I3) { per = 32 * 32; const int mi = r / per; c.W = a.ret_w_out + (size_t)mi * 2048 * 1024; c.WT = a.ws + WS_WRO + (size_t)mi * 1024 * 2048; c.K = 2048; c.N = 1024; c.scale = WRO_SCALE; r -= mi * per; }
    else if ((r -= I3) < I4) { per = 16 * 64; const int mi = r / per; c.W = a.moe_w1 + (size_t)mi * 1024 * 2048; c.WT = a.ws + WS_W1 + (size_t)mi * 2048 * 1024; c.K = 1024; c.N = 2048; c.scale = W1_SCALE; r -= mi * per; }
    else { r -= I4; per = 16 * 32; const int mi = r / per; c.W = a.moe_w2 + (size_t)mi * 1024 * 1024; c.WT = a.ws + WS_W2 + (size_t)mi * 1024 * 1024; c.K = 1024; c.N = 1024; c.scale = W2_SCALE; r -= mi * per; }
    nblk = c.N / 32; c.k0 = 64 * (r / nblk); c.n0 = 32 * (r % nblk); return c;
}
__device__ __forceinline__ void conv_load(const ConvItem& c, int lane, f32x4 (&v)[8]) {
    const GAS float* p = (const GAS float*)c.W + (size_t)(c.k0 + 8 * (lane >> 3)) * c.N + c.n0 + 4 * (lane & 7);
#pragma unroll
    for (int i = 0; i < 8; ++i) v[i] = __builtin_nontemporal_load((const GAS f32x4*)(p + (size_t)i * c.N));
}
__device__ __forceinline__ void conv_finish(const ConvItem& c, int lane, const f32x4 (&v)[8]) {
    unsigned char* dst = c.WT + (size_t)(c.n0 + 4 * (lane & 7)) * c.K + c.k0 + 8 * (lane >> 3);
#pragma unroll
    for (int z = 0; z < 4; ++z) { v2u w;
        w.x = pg8::pack_fp8x4(v[0][z] * c.scale, v[1][z] * c.scale, v[2][z] * c.scale, v[3][z] * c.scale);
        w.y = pg8::pack_fp8x4(v[4][z] * c.scale, v[5][z] * c.scale, v[6][z] * c.scale, v[7][z] * c.scale);
        *(GAS v2u*)(dst + (size_t)z * c.K) = w; }
}
__device__ __forceinline__ void deferred_conversion(const Frame& F0, const Args& a) {
    const Frame F = relaunder(F0);
    const int gw = F.vcu * 8 + F.wave, NGW = F.G * 8;
    constexpr int NDEF = 2 * 16 * 192 + 2 * 32 * 32 + 128 * 16 * 64 + 128 * 16 * 32;
    if (gw >= NDEF) return;
    const int n = (NDEF - gw + NGW - 1) / NGW;
    f32x4 va[8], vb[8], vc[8], vd[8];
#define CV_ITEM(j_) conv_decode(a, gw + ((j_) < n ? (j_) : n - 1) * NGW)
    conv_load(CV_ITEM(0), F.lane, va); conv_load(CV_ITEM(1), F.lane, vb); conv_load(CV_ITEM(2), F.lane, vc); conv_load(CV_ITEM(3), F.lane, vd);
#pragma unroll 1
    for (int j = 0; j < n; j += 4) {
        conv_finish(CV_ITEM(j), F.lane, va); conv_load(CV_ITEM(j + 4), F.lane, va);
        conv_finish(CV_ITEM(j + 1), F.lane, vb); conv_load(CV_ITEM(j + 5), F.lane, vb);
        conv_finish(CV_ITEM(j + 2), F.lane, vc); conv_load(CV_ITEM(j + 6), F.lane, vc);
        conv_finish(CV_ITEM(j + 3), F.lane, vd); conv_load(CV_ITEM(j + 7), F.lane, vd);
    }
#undef CV_ITEM
}
#ifndef DEFER_CONV
#define DEFER_CONV (RET_FP8 && RO_FP8)
#endif
__device__ __forceinline__ void prologue_phase(const Frame& F0, const Args& a) {
    const Frame F = relaunder(F0);
    LAS float* scr = (LAS float*)(F.lds + F.wave * 16384);
    const int gw = F.vcu * 8 + F.wave, NGW = F.G * 8;
    constexpr int I0 = 2 * 16 * 96, I1 = 2 * 16 * 32, I2 = 2 * 16 * 192, I3 = 2 * 32 * 32, I4 = 128 * 16 * 64, I5 = 128 * 16 * 32;
    constexpr int NITEMS = I0 + I1 + I2 + I3 + I4 + I5;
    for (int it = gw; it < (DEFER_CONV ? I0 + I1 : NITEMS); it += NGW) {
        int r = it;
        if (r < I0) { const int per = 16 * 96, mi = r / per; if (QKV_FP8) transpose_item_fp8(a.diff_w_in + (size_t)mi * 1024 * 3072, 1024, 3072, a.ws + WS_WDI + (size_t)mi * 3072 * 1024, WRI_SCALE, scr, r % per, F.lane); else transpose_item(a.diff_w_in + (size_t)mi * 1024 * 3072, 1024, 3072, (bf16*)(a.ws + WS_WDI) + (size_t)mi * 3072 * 1024, scr, r % per, F.lane); continue; } r -= I0;
        if (r < I1) { const int per = 16 * 32, mi = r / per; if (DO_FP8) transpose_item_fp8(a.diff_w_out + (size_t)mi * 1024 * 1024, 1024, 1024, a.ws + WS_WDO + (size_t)mi * 1024 * 1024, WDO_SCALE, scr, r % per, F.lane); else transpose_item(a.diff_w_out + (size_t)mi * 1024 * 1024, 1024, 1024, (bf16*)(a.ws + WS_WDO) + (size_t)mi * 1024 * 1024, scr, r % per, F.lane); continue; } r -= I1;
        if (r < I2) { const int per = 16 * 192, mi = r / per; if (RET_FP8) transpose_item_fp8(a.ret_w_in + (size_t)mi * 1024 * 6144, 1024, 6144, a.ws + WS_WRI + (size_t)mi * 6144 * 1024, WRI_SCALE, scr, r % per, F.lane);
            else transpose_item(a.ret_w_in + (size_t)mi * 1024 * 6144, 1024, 6144, (bf16*)(a.ws + WS_WRI) + (size_t)mi * 6144 * 1024, scr, r % per, F.lane); continue; } r -= I2;
        if (r < I3) { const int per = 32 * 32, mi = r / per; if (RO_FP8) transpose_item_fp8(a.ret_w_out + (size_t)mi * 2048 * 1024, 2048, 1024, a.ws + WS_WRO + (size_t)mi * 1024 * 2048, WRO_SCALE, scr, r % per, F.lane); else transpose_item(a.ret_w_out + (size_t)mi * 2048 * 1024, 2048, 1024, (bf16*)(a.ws + WS_WRO) + (size_t)mi * 1024 * 2048, scr, r % per, F.lane); continue; } r -= I3;
        if (r < I4) { const int per = 16 * 64, mi = r / per; transpose_item_fp8(a.moe_w1 + (size_t)mi * 1024 * 2048, 1024, 2048, a.ws + WS_W1 + (size_t)mi * 2048 * 1024, W1_SCALE, scr, r % per, F.lane); continue; } r -= I4;
        { const int per = 16 * 32, mi = r / per; transpose_item_fp8(a.moe_w2 + (size_t)mi * 1024 * 1024, 1024, 1024, a.ws + WS_W2 + (size_t)mi * 1024 * 1024, W2_SCALE, scr, r % per, F.lane); }
    }
    { bf16* wg = (bf16*)(a.ws + WS_WRT);
      for (int idx = gw * 64 + F.lane; idx < DEPTH * DM * NEXP; idx += NGW * 64) { const int l = idx >> 15, r = idx & 32767, e = r & 31, k = r >> 5;
          const float w = ((const GAS float*)a.moe_rw)[idx] * ((const GAS float*)a.moe_norm)[l * DM + k];
          const unsigned hi = cvtpk(w, 0.f) & 0xffffu; const unsigned lo = cvtpk(w - __uint_as_float(hi << 16), 0.f) & 0xffffu;
          ((GAS bf16*)wg)[(size_t)l * (2 * NEXP * WRP) + e * WRP + k] = (bf16)hi; ((GAS bf16*)wg)[(size_t)l * (2 * NEXP * WRP) + NEXP * WRP + e * WRP + k] = (bf16)lo; } }
    f32x4 g[4]; load_row(a.diff_norm, F.lane, g);
    bf16* HB = (bf16*)(a.ws + WS_HB);
    for (int m = gw; m < NTOK; m += NGW) { f32x4 v[4], h[4]; { const GAS f32x4* px_ = (const GAS f32x4*)(a.x + (size_t)m * DM) + F.lane;
#pragma unroll
        for (int j = 0; j < 4; ++j) v[j] = __builtin_nontemporal_load(px_ + 64 * j); }
        rms_row(v, g, h);
        if (QKV_FP8) { GAS unsigned* o8 = (GAS unsigned*)(a.ws + WS_HB8 + (size_t)m * DM) + F.lane;
#pragma unroll
            for (int j = 0; j < 4; ++j) o8[64 * j] = pg8::pack_fp8x4(h[j][0] * H8_SCALE, h[j][1] * H8_SCALE, h[j][2] * H8_SCALE, h[j][3] * H8_SCALE); }
        else store_row_bf16(HB + (size_t)m * DM, F.lane, h);
        store_row_bf16((bf16*)(a.ws + WS_XB) + (size_t)m * DM, F.lane, v); }
}

__device__ __forceinline__ void compute_toff(const Frame& F, const int* cnt) {
    if (opaque_tid() == 0) { int acc = 0;
        for (int e = 0; e < NEXP; ++e) { const int c_ = ((const GAS int*)cnt)[e]; F.misc[MI_TOFF + e] = acc; F.misc[MI_TOFF + 128 + e] = c_; acc += (c_ + 255) >> 8; }
        F.misc[MI_TOFF + 32] = acc; }
    __syncthreads();
    { LAS unsigned char* texp = (LAS unsigned char*)F.misc + 4 * MI_STG; const int TM = F.misc[MI_TOFF + 32];
      for (int t = opaque_tid(); t < TM; t += 512) { int e = 0;
#pragma unroll
          for (int k = 1; k < 32; ++k) e += (F.misc[MI_TOFF + k] <= t) ? 1 : 0;
          texp[t] = (unsigned char)e; } }
    __syncthreads();
}

__device__ __forceinline__ void tb_phase(const Frame& F0, const Args& a, int layer) {
    const Frame F = relaunder(F0);
    const float* rb = a.moe_rb + layer * NEXP;
    int* gcnt = (int*)(a.ws + WS_CTL) + CW_CNT + layer * NEXP;
    int* list = (int*)(a.ws + WS_LIST); int* tslot = (int*)(a.ws + WS_TSLOT); float* tgate = (float*)(a.ws + WS_TGATE); float* lrs = (float*)(a.ws + WS_LRS);
    unsigned char* HB8 = a.ws + WS_HB8;
    LAS bf16* WrT = (LAS bf16*)F.lds;
    { const GAS v4u* src = (const GAS v4u*)((const bf16*)(a.ws + WS_WRT) + (size_t)layer * (2 * NEXP * WRP));
      constexpr int NV = 2 * NEXP * WRP / 8, NFULL = NV / 512;
      v4u t_[NFULL];
#pragma unroll
      for (int i = 0; i < NFULL; ++i) t_[i] = src[F.tid + 512 * i];
      v4u tail_ = {0u, 0u, 0u, 0u}; if (F.tid < NV - 512 * NFULL) tail_ = src[512 * NFULL + F.tid];
#pragma unroll
      for (int i = 0; i < NFULL; ++i) ((LAS v4u*)WrT)[F.tid + 512 * i] = t_[i];
      if (F.tid < NV - 512 * NFULL) ((LAS v4u*)WrT)[512 * NFULL + F.tid] = tail_; }
    LAS int* lcnt = F.misc + MI_LCNT; LAS int* lbase = F.misc + MI_LBASE;
    LAS float* scr = (LAS float*)(F.lds + (F.wave < 6 ? 2 * NEXP * WRP * 2 + 2048 * F.wave : MISC_OFF + 12288 + 2048 * (F.wave - 6)));
    LAS unsigned* st_ep = (LAS unsigned*)(F.misc + MI_STEP); LAS float* st_g = (LAS float*)(F.misc + MI_STG); LAS float* st_r = (LAS float*)(F.misc + MI_STR);
    const int e_me = F.lane & 31, hsel = F.lane >> 5, r16 = F.lane & 15, kq = F.lane >> 4;
    const float bv0 = ((const GAS float*)rb)[r16], bv1 = ((const GAS float*)rb)[16 + r16];
    for (int bt = F.vcu; bt < NTOK / 256; bt += F.G) {
        if (F.tid < 32) lcnt[F.tid] = 0;
        __syncthreads();
#pragma unroll 1
        for (int gi = 0; gi < 2; ++gi) {
            const int rl0 = F.wave * 32 + 16 * gi; const size_t row = (size_t)bt * 256 + rl0 + r16;
            const GAS v4u* dp = (const GAS v4u*)(a.ws + WS_XB + (row * DM + 16 * kq) * 2);
            GAS v4u* op = (GAS v4u*)(HB8 + row * DM + 16 * kq);
            const LAS bf16* wp = WrT + r16 * WRP + 16 * kq;
            const GAS f32x4* gp = (const GAS f32x4*)(a.moe_norm + (size_t)layer * DM + 16 * kq);
            f32x4 acc0 = {0.f, 0.f, 0.f, 0.f}, acc1 = {0.f, 0.f, 0.f, 0.f}; float ss = 0.f;
            v4u da[2], db[2];
            da[0] = dp[0]; da[1] = dp[1]; db[0] = dp[8]; db[1] = dp[9];
#define TB_STEP(dc, T_) do { const int T = (T_); f32x4 v[4]; \
                v[0] = (f32x4){bflo(dc[0].x), bfhi(dc[0].x), bflo(dc[0].y), bfhi(dc[0].y)}; \
                v[1] = (f32x4){bflo(dc[0].z), bfhi(dc[0].z), bflo(dc[0].w), bfhi(dc[0].w)}; \
                v[2] = (f32x4){bflo(dc[1].x), bfhi(dc[1].x), bflo(dc[1].y), bfhi(dc[1].y)}; \
                v[3] = (f32x4){bflo(dc[1].z), bfhi(dc[1].z), bflo(dc[1].w), bfhi(dc[1].w)}; \
                _Pragma("unroll") for (int z = 0; z < 4; ++z) ss += (v[z][0] * v[z][0] + v[z][1] * v[z][1]) + (v[z][2] * v[z][2] + v[z][3] * v[z][3]); \
                _Pragma("unroll") for (int z = 0; z < 4; ++z) v[z] = v[z] * gp[16 * T + z]; \
                const bf16x8 a0 = __builtin_bit_cast(bf16x8, dc[0]), a1 = __builtin_bit_cast(bf16x8, dc[1]);     \
                { const int Tn = T + 2 < 16 ? T + 2 : T; \
                  dc[0] = dp[8 * Tn]; dc[1] = dp[8 * Tn + 1]; } \
                v4u o; \
                o.x = pg8::pack_fp8x4(v[0][0] * H8U_SCALE, v[0][1] * H8U_SCALE, v[0][2] * H8U_SCALE, v[0][3] * H8U_SCALE); \
                o.y = pg8::pack_fp8x4(v[1][0] * H8U_SCALE, v[1][1] * H8U_SCALE, v[1][2] * H8U_SCALE, v[1][3] * H8U_SCALE); \
                o.z = pg8::pack_fp8x4(v[2][0] * H8U_SCALE, v[2][1] * H8U_SCALE, v[2][2] * H8U_SCALE, v[2][3] * H8U_SCALE); \
                o.w = pg8::pack_fp8x4(v[3][0] * H8U_SCALE, v[3][1] * H8U_SCALE, v[3][2] * H8U_SCALE, v[3][3] * H8U_SCALE); \
                op[4 * T] = o; \
                _Pragma("unroll") for (int s_ = 0; s_ < 2; ++s_) { const bf16x8 av = s_ ? a1 : a0; const LAS bf16* w_ = wp + 64 * T + 8 * s_; \
                    acc0 = __builtin_amdgcn_mfma_f32_16x16x32_bf16(av, *(const LAS bf16x8*)(w_), acc0, 0, 0, 0); \
                    acc1 = __builtin_amdgcn_mfma_f32_16x16x32_bf16(av, *(const LAS bf16x8*)(w_ + 16 * WRP), acc1, 0, 0, 0); \
                    acc0 = __builtin_amdgcn_mfma_f32_16x16x32_bf16(av, *(const LAS bf16x8*)(w_ + NEXP * WRP), acc0, 0, 0, 0); \
                    acc1 = __builtin_amdgcn_mfma_f32_16x16x32_bf16(av, *(const LAS bf16x8*)(w_ + NEXP * WRP + 16 * WRP), acc1, 0, 0, 0); } } while (0)
#pragma unroll 1
            for (int T2 = 0; T2 < 8; ++T2) { TB_STEP(da, 2 * T2); TB_STEP(db, 2 * T2 + 1); }
#undef TB_STEP
            { const int l_ = lane_now(); ss += shfl_xor_(ss, 16, l_); ss += shfl_xor_(ss, 32, l_); }
            const float rstd = 1.0f / sqrtf(ss * (1.0f / DM) + NORM_EPS);
            if (F.lane < 16) st_r[rl0 + F.lane] = rstd;
#pragma unroll
            for (int i = 0; i < 4; ++i) { const float ri = shfl_idx_(rstd, 4 * kq + i);
                scr[(4 * kq + i) * 32 + r16] = acc0[i] * ri + bv0; scr[(4 * kq + i) * 32 + 16 + r16] = acc1[i] * ri + bv1; }
            asm volatile("s_waitcnt lgkmcnt(0)" ::: "memory");
#pragma unroll 1
            for (int it = 0; it < 8; ++it) {
                const int rowl = rl0 + 2 * it;
                const LAS float* lrow = scr + (2 * it + hsel) * 32;
                const float val = lrow[e_me];
                int rank = 0;
#pragma unroll
                for (int q = 0; q < 8; ++q) { const f32x4 t = *(const LAS f32x4*)(lrow + 4 * q);
#pragma unroll
                    for (int z = 0; z < 4; ++z) { const int ee = 4 * q + z; rank += (t[z] > val || (t[z] == val && ee < e_me)) ? 1 : 0; } }
                float vA[4], vB[4]; int eA[4], eB[4];
#pragma unroll
                for (int k = 0; k < 4; ++k) { const unsigned long long mk = __ballot(rank == k);
                    const int la = __builtin_amdgcn_readfirstlane(__builtin_ctz((unsigned)(mk & 0xffffffffull) | 0x80000000u));
                    const int lb = __builtin_amdgcn_readfirstlane(__builtin_ctz((unsigned)(mk >> 32) | 0x80000000u));
                    eA[k] = la; eB[k] = lb;
                    vA[k] = __uint_as_float(__builtin_amdgcn_readlane(__float_as_uint(val), la)); vB[k] = __uint_as_float(__builtin_amdgcn_readlane(__float_as_uint(val), 32 + lb)); }
                float gA[4], gB[4]; float sA = 0.f, sB = 0.f;
#pragma unroll
                for (int k = 0; k < 4; ++k) { gA[k] = __expf(vA[k] - vA[0]); gB[k] = __expf(vB[k] - vB[0]); sA += gA[k]; sB += gB[k]; }
                if (F.lane < 8) { const int r = F.lane >> 2, k = F.lane & 3;
                    const int e0 = r ? eB[0] : eA[0], e1 = r ? eB[1] : eA[1], e2 = r ? eB[2] : eA[2], e3 = r ? eB[3] : eA[3];
                    const float g0 = r ? gB[0] : gA[0], g1 = r ? gB[1] : gA[1], g2 = r ? gB[2] : gA[2], g3 = r ? gB[3] : gA[3];
                    const int e_ = k == 0 ? e0 : (k == 1 ? e1 : (k == 2 ? e2 : e3)); const float g_ = (k == 0 ? g0 : (k == 1 ? g1 : (k == 2 ? g2 : g3))) / (r ? sB : sA);
                    const int pl = atomicAdd((int*)(lcnt + e_), 1);
                    st_ep[(rowl + r) * 4 + k] = (unsigned)e_ | ((unsigned)pl << 8); st_g[(rowl + r) * 4 + k] = g_; }
            }
        }
        __syncthreads();
        if (F.tid < 32) lbase[F.tid] = atomicAdd(gcnt + F.tid, lcnt[F.tid]);
        __syncthreads();
        for (int idx = F.tid; idx < 1024; idx += 512) { const int rowl = idx >> 2, k = idx & 3; const unsigned ep = st_ep[idx]; const int e = (int)(ep & 255u); const int pos = lbase[e] + (int)(ep >> 8);
            const int tok = bt * 256 + rowl; ((GAS int*)list)[(size_t)e * NTOK + pos] = tok; ((GAS float*)lrs)[(size_t)e * NTOK + pos] = st_r[rowl]; ((GAS int*)tslot)[tok * 4 + k] = (e << 20) | pos; ((GAS float*)tgate)[tok * 4 + k] = st_g[idx]; }
        __syncthreads();
    }
}

__device__ __forceinline__ void tc_phase(const Frame& F0, const Args& a, bool last  , const float* gain  , bool h8, bool dry = false) {
    const Frame F = relaunder(F0);
    const int* tslot = (const int*)(a.ws + WS_TSLOT); const float* tgate = (const float*)(a.ws + WS_TGATE);
    const bf16* Y = (const bf16*)(a.ws + WS_Y); bf16* HB = (bf16*)(a.ws + WS_HB);
    f32x4 g[4];
    if (gain) load_row(gain, F.lane, g);
    const int gw = F.vcu * 8 + F.wave, NGW = F.G * 8;
    for (int m = gw; m < NTOK; m += NGW) {
        f32x4 v[4];
        { const GAS v2u* dr = (const GAS v2u*)(a.ws + WS_XB + (size_t)m * DM * 2) + F.lane;
#pragma unroll
          for (int j = 0; j < 4; ++j) { const v2u w = dr[64 * j]; v[j][0] = bflo(w.x); v[j][1] = bfhi(w.x); v[j][2] = bflo(w.y); v[j][3] = bfhi(w.y); } }
#pragma unroll
        for (int k = 0; k < 4; ++k) { const int ts = ((const GAS int*)tslot)[m * 4 + k]; const float gt = ((const GAS float*)tgate)[m * 4 + k]; const int e = ts >> 20, pos = ts & 0xfffff;
            const size_t slot = (size_t)F.misc[MI_TOFF + e] * 256 + pos;
            if (Y_FP8) { const GAS int* yr = (const GAS int*)((const unsigned char*)Y + slot * DM) + F.lane; const float g8 = gt * (1.0f / Y8_SCALE);
#pragma unroll
                for (int j = 0; j < 4; ++j) { const int w = __builtin_nontemporal_load(yr + 64 * j); const f32x2 lo = __builtin_amdgcn_cvt_pk_f32_fp8(w, false), hi = __builtin_amdgcn_cvt_pk_f32_fp8(w, true);
                    v[j][0] += g8 * lo.x; v[j][1] += g8 * lo.y; v[j][2] += g8 * hi.x; v[j][3] += g8 * hi.y; } }
            else { const GAS v2u* yr = (const GAS v2u*)(Y + slot * DM) + F.lane;
#pragma unroll
                for (int j = 0; j < 4; ++j) { const v2u w = yr[64 * j]; v[j][0] += gt * bflo(w.x); v[j][1] += gt * bfhi(w.x); v[j][2] += gt * bflo(w.y); v[j][3] += gt * bfhi(w.y); } } }
        if (!dry) {
            if (last) { GAS f32x4* o = (GAS f32x4*)(a.out + (size_t)m * DM) + F.lane;
#pragma unroll
                for (int j = 0; j < 4; ++j) o[64 * j] = v[j]; }
            else store_row_bf16((bf16*)(a.ws + WS_XB) + (size_t)m * DM, F.lane, v); }
        if (gain) { f32x4 h[4]; rms_row(v, g, h);
            if (h8) { GAS unsigned* o8 = (GAS unsigned*)(a.ws + WS_HB8 + (size_t)m * DM) + F.lane;
#pragma unroll
                for (int j = 0; j < 4; ++j) o8[64 * j] = pg8::pack_fp8x4(h[j][0] * H8_SCALE, h[j][1] * H8_SCALE, h[j][2] * H8_SCALE, h[j][3] * H8_SCALE); }
            else store_row_bf16(HB + (size_t)m * DM, F.lane, h); }
    }
}

__device__ __forceinline__ void td_phase(const Frame& F0, const Args& a) {
    const Frame F = relaunder(F0);
    const bf16* OF = (const bf16*)(a.ws + WS_ROF); const bf16* OB = (const bf16*)(a.ws + WS_ROB); const bf16* RG = (const bf16*)(a.ws + WS_PROJ + 640 * MiB); bf16* GO = (bf16*)(a.ws + WS_RGO);
    const int gw = F.vcu * 8 + F.wave, NGW = F.G * 8;
    for (int m = gw; m < NTOK; m += NGW) {
#pragma unroll
        for (int hd = 0; hd < 4; ++hd) { const size_t off = (size_t)m * 2048 + hd * 512 + 8 * F.lane;
            const v4u f = __builtin_nontemporal_load((const GAS v4u*)(OF + off)), b = __builtin_nontemporal_load((const GAS v4u*)(OB + off)), gg = __builtin_nontemporal_load((const GAS v4u*)(RG + off));
            float o[8]; o[0] = bflo(f.x) + bflo(b.x); o[1] = bfhi(f.x) + bfhi(b.x); o[2] = bflo(f.y) + bflo(b.y); o[3] = bfhi(f.y) + bfhi(b.y);
            o[4] = bflo(f.z) + bflo(b.z); o[5] = bfhi(f.z) + bfhi(b.z); o[6] = bflo(f.w) + bflo(b.w); o[7] = bfhi(f.w) + bfhi(b.w);
            float s = 0.f;
#pragma unroll
            for (int i = 0; i < 8; ++i) s += o[i] * o[i];
            const float rstd = 1.0f / sqrtf(wave_sum(s) * (1.0f / 512.0f) + NORM_EPS);
            float gv[8]; gv[0] = bflo(gg.x); gv[1] = bfhi(gg.x); gv[2] = bflo(gg.y); gv[3] = bfhi(gg.y); gv[4] = bflo(gg.z); gv[5] = bfhi(gg.z); gv[6] = bflo(gg.w); gv[7] = bfhi(gg.w);
#pragma unroll
            for (int i = 0; i < 8; ++i) { const float sg = gv[i] * __builtin_amdgcn_rcpf(1.0f + __builtin_amdgcn_exp2f(-LOG2E * gv[i])); o[i] = o[i] * rstd * sg; }
            if (RO_FP8) { v2u w; w.x = pg8::pack_fp8x4(o[0] * GO8_SCALE, o[1] * GO8_SCALE, o[2] * GO8_SCALE, o[3] * GO8_SCALE); w.y = pg8::pack_fp8x4(o[4] * GO8_SCALE, o[5] * GO8_SCALE, o[6] * GO8_SCALE, o[7] * GO8_SCALE);
                *(GAS v2u*)((unsigned char*)GO + off) = w; }
            else { v4u w; w.x = cvtpk(o[0], o[1]); w.y = cvtpk(o[2], o[3]); w.z = cvtpk(o[4], o[5]); w.w = cvtpk(o[6], o[7]);
                *(GAS v4u*)(GO + off) = w; } }
    }
}

constexpr int N_PHASES = 1 + 9 * DEPTH;
#ifndef MOE_ALIGN
#define MOE_ALIGN true
#endif
__global__ void __launch_bounds__(512, 2) fwd_kernel(Args a) {
    static_assert(WTAB_BYTES == MISC_OFF + 4 * 192, "wave table location");
    static_assert(pg8::TEXP_REL == 4 * MI_STG - 4 * MI_TOFF && pg8::PARK_OFF == MISC_OFF + 12288 && pg8::LISTPARK_OFF == MISC_OFF + 4 * MI_STEP, "park buffers");
    Frame F;
    F.lds = (LAS unsigned char*)lds_raw; F.misc = (LAS int*)(F.lds + MISC_OFF);
    F.tid = threadIdx.x; F.lane = F.tid & 63; F.wave = __builtin_amdgcn_readfirstlane(F.tid >> 6);
    F.G = gridDim.x; { const int bx = blockIdx.x; F.vcu = (F.G % 8 == 0) ? (bx % 8) * (F.G / 8) + bx / 8 : bx; }
    for (int u = F.tid; u < (LDS_BYTES - MISC_OFF) / 4; u += 512) F.misc[u] = 0;
    __syncthreads();
    if (F.lane == 0) F.misc[192 + hw_wave_slot()] = F.wave;
    __syncthreads();
    unsigned* barw = (unsigned*)(a.ws + WS_CTL) + CW_BAR;
    const int lo = a.ph_lo, hi = a.ph_hi;
    XcdBarrier bar; bar.bar = barw; bar.x = 0; bar.st = nullptr;
    if (hi - lo > 1) bar = xcd_barrier_post(barw, (volatile LAS unsigned*)F.misc);
#ifndef PH_MASK
#define PH_MASK 0xffff
#endif
#define PHM(b) ((PH_MASK >> (b)) & 1)
#ifndef REP_MASK
#define REP_MASK 0
#endif
#define REPS(b) ((((REP_MASK) >> (b)) & 1) ? 2 : 1)
#define RUN(k) (lo <= (k) && (k) < hi)
#ifdef BAR_TWICE
#define AFTER(k) do { if ((k) + 1 < hi) { xcd_barrier(bar); xcd_barrier(bar); } } while (0)
#else
#define AFTER(k) do { if ((k) + 1 < hi) xcd_barrier(bar); } while (0)
#endif
    unsigned char* ws = a.ws;
    bf16* HB;
    if (PHM(0) && RUN(0)) { for (int rep_ = 0; rep_ < REPS(0); ++rep_) { if (rep_) xcd_barrier(bar); prologue_phase(F, a); } AFTER(0); }
#pragma unroll 1
    for (int i = 0; i < DEPTH; ++i) {
        const int pb = 1 + 9 * i, jl = i >> 1;
        ws = opaque_ptr(ws); HB = (bf16*)(ws + WS_HB);
        if ((i & 1) == 0) {
            bf16* Qb = (bf16*)(ws + WS_PROJ); bf16* Kb = (bf16*)(ws + WS_PROJ + 128 * MiB); bf16* Vb = (bf16*)(ws + WS_PROJ + 256 * MiB); bf16* AO = (bf16*)(ws + WS_AO);
            if (PHM(1) && RUN(pb + 0)) { for (int rep_ = 0; rep_ < REPS(1); ++rep_) { if (rep_) xcd_barrier(bar);
                pg8::DenseProb<1024, 2, QKV_FP8 != 0> P{QKV_FP8 ? (const void*)(ws + WS_HB8) : (const void*)HB, QKV_FP8 ? (const void*)(ws + WS_WDI + (size_t)jl * 3072 * 1024) : (const void*)((const bf16*)(ws + WS_WDI) + (size_t)jl * 3072 * 1024), NTOK / 256, 12, F.G, F.vcu};
                pg8::EpiQKV E{Qb, Kb, Vb, a.qn + jl * 64, a.kn + jl * 64, QKV_FP8 ? 1.0f / (H8_SCALE * WRI_SCALE) : 1.0f};
                pg8::gemm_phase<pg8::DenseProb<1024, 2, QKV_FP8 != 0>, pg8::EpiQKV, true>(F.lds, P, E);
                } AFTER(pb + 0);
            }
            if (PHM(2) && RUN(pb + 2)) { for (int rep_ = 0; rep_ < REPS(2); ++rep_) { if (rep_) xcd_barrier(bar);
                const int ln_ = lane_now();
                float s1 = ((const GAS float*)a.lq1)[jl * 64 + ln_] * ((const GAS float*)a.lk1)[jl * 64 + ln_], s2 = ((const GAS float*)a.lq2)[jl * 64 + ln_] * ((const GAS float*)a.lk2)[jl * 64 + ln_];
                s1 = wave_sum(s1); s2 = wave_sum(s2);
                const float linit = 0.8f - 0.6f * expf(-0.3f * (float)i);
                float gq = fabsf(((const GAS float*)a.qn)[jl * 64 + ln_]), gk = fabsf(((const GAS float*)a.kn)[jl * 64 + ln_]);
#pragma unroll
                for (int o_ = 1; o_ < 64; o_ <<= 1) { gq = fmaxf(gq, shfl_xor_(gq, o_, ln_)); gk = fmaxf(gk, shfl_xor_(gk, o_, ln_)); }
                const float lam_u = __uint_as_float(__builtin_amdgcn_readfirstlane(__float_as_uint(expf(s1) - expf(s2) + linit)));
                att::AttnArgs A{Qb, Kb, Vb, AO, lam_u, a.subln + jl * 128, 1.0f - linit, 8.1f * gq * gk};
                for (int u = F.vcu; u < NBATCH * 8 * 16; u += F.G) { const int bq = u % (NBATCH * 16), h = u / (NBATCH * 16); att::attn_unit(bq >> 4, h, h == 3 ? ((bq + 8) & 15) : (bq & 15), A, (LAS char*)F.lds);
                    if (DEFER_CONV && i == 0 && rep_ == 0 && h == 2 + (F.vcu % 5)) { deferred_conversion(F, a); } }
#ifdef ATT_TWICE
                xcd_barrier(bar);
                for (int u = F.vcu; u < NBATCH * 8 * 16; u += F.G) { const int bq = u % (NBATCH * 16), h = u / (NBATCH * 16); att::attn_unit(bq >> 4, h, h == 3 ? ((bq + 8) & 15) : (bq & 15), A, (LAS char*)F.lds); }
#endif
                } AFTER(pb + 2);
            }
            if (PHM(3) && RUN(pb + 4)) {
                pg8::DenseProb<1024, 1, DO_FP8 != 0> P{AO, DO_FP8 ? (const void*)(ws + WS_WDO + (size_t)jl * 1024 * 1024) : (const void*)((const bf16*)(ws + WS_WDO) + (size_t)jl * 1024 * 1024), NTOK / 256, 4, F.G, F.vcu};
                pg8::EpiDelta E{(bf16*)(ws + WS_XB), DO_FP8 ? 1.0f / (AO8_SCALE * WDO_SCALE) : 1.0f};
                pg8::gemm_phase<pg8::DenseProb<1024, 1, DO_FP8 != 0>, pg8::EpiDelta, true>(F.lds, P, E);
                AFTER(pb + 4);
            }
        } else {
            bf16* RQ = (bf16*)(ws + WS_PROJ); bf16* RKF = (bf16*)(ws + WS_PROJ + 128 * MiB); bf16* RKB = (bf16*)(ws + WS_PROJ + 256 * MiB); bf16* RV = (bf16*)(ws + WS_PROJ + 384 * MiB); bf16* RG = (bf16*)(ws + WS_PROJ + 640 * MiB);
            bf16* RP = (bf16*)(ws + WS_RP);
            if (PHM(4) && RUN(pb + 0)) { for (int rep_ = 0; rep_ < REPS(4); ++rep_) { if (rep_) xcd_barrier(bar);
                pg8::DenseProb<1024, 1, RET_FP8 != 0> P{RET_FP8 ? (const void*)(ws + WS_HB8) : (const void*)HB, RET_FP8 ? (const void*)(ws + WS_WRI + (size_t)jl * 6144 * 1024) : (const void*)((const bf16*)(ws + WS_WRI) + (size_t)jl * 6144 * 1024), NTOK / 256, 24, F.G, F.vcu};
                pg8::EpiRetIn E{RQ, RKF, RKB, RV, RG, a.lgf + jl * 4, a.lgb + jl * 4, RET_FP8 ? 1.0f / (H8_SCALE * WRI_SCALE) : 1.0f};
                pg8::gemm_phase<pg8::DenseProb<1024, 1, RET_FP8 != 0>, pg8::EpiRetIn, true>(F.lds, P, E);
                } AFTER(pb + 0);
            }
            if (PHM(5) && RUN(pb + 1)) { for (int rep_ = 0; rep_ < REPS(5); ++rep_) { if (rep_) xcd_barrier(bar);
                const int gw = F.vcu * 8 + F.wave, NGW = F.G * 8;
                for (int u = gw; u < NBATCH * 4 * 128; u += NGW) { const int sc = u & 127, h = (u >> 7) & 3, b = u >> 9; ret::rp_unit(b, h, sc, RQ, RKF, RKB, RP, a.lgf[jl * 4 + h], a.lgb[jl * 4 + h]); }
                } AFTER(pb + 1);
            }
            if (PHM(6) && RUN(pb + 2)) { for (int rep_ = 0; rep_ < REPS(6); ++rep_) { if (rep_) xcd_barrier(bar);
                for (int u = F.vcu; u < NBATCH * 4 * 2 * 2; u += F.G) { const int vs = u & 1, dir = (u >> 1) & 1, h = (u >> 2) & 3, b = u >> 4;
                    ret::ChainArgs A{RQ, dir ? RKB : RKF, RV, RP, (bf16*)(ws + (dir ? WS_ROB : WS_ROF)), dir ? a.lgb[jl * 4 + h] : a.lgf[jl * 4 + h]};
                    ret::chain_unit(b, h, dir, vs, A, (LAS char*)F.lds); }
                } AFTER(pb + 2);
            }
            if (PHM(7) && RUN(pb + 3)) { for (int rep_ = 0; rep_ < REPS(7); ++rep_) { if (rep_) xcd_barrier(bar); td_phase(F, a); } AFTER(pb + 3); }
            if (PHM(8) && RUN(pb + 4)) {
                pg8::DenseProb<2048, 1, RO_FP8 != 0> P{(const void*)(ws + WS_RGO), RO_FP8 ? (const void*)(ws + WS_WRO + (size_t)jl * 1024 * 2048) : (const void*)((const bf16*)(ws + WS_WRO) + (size_t)jl * 1024 * 2048), NTOK / 256, 4, F.G, F.vcu};
                pg8::EpiDelta E{(bf16*)(ws + WS_XB), RO_FP8 ? 1.0f / (GO8_SCALE * WRO_SCALE) : 1.0f};
                pg8::gemm_phase<pg8::DenseProb<2048, 1, RO_FP8 != 0>, pg8::EpiDelta, true>(F.lds, P, E);
                AFTER(pb + 4);
            }
        }
        const int* cnt = (const int*)(ws + WS_CTL) + CW_CNT + i * NEXP;
        if (PHM(9) && RUN(pb + 5)) {
            if (REPS(9) == 2) { tb_phase(F, a, i); xcd_barrier(bar); { const int t_ = opaque_tid(); if (blockIdx.x == 0 && t_ < NEXP) ((GAS int*)(ws + WS_CTL))[CW_CNT + i * NEXP + t_] = 0; } xcd_barrier(bar); }
            tb_phase(F, a, i); AFTER(pb + 5); }
        if (PHM(10) && RUN(pb + 6)) { for (int rep_ = 0; rep_ < REPS(10); ++rep_) { if (rep_) xcd_barrier(bar);
            compute_toff(F, cnt);
            pg8::MoeProb<1024, true, 3> P{ws + WS_HB8, ws + WS_W1 + (size_t)i * NEXP * 2048 * 1024, (size_t)2048 * 1024, (const int*)(ws + WS_LIST), cnt, F.misc + MI_TOFF, 8, F.G, F.vcu};
            pg8::EpiSwiglu E{ws + WS_ACT, a.moe_b1 + (size_t)i * NEXP * 2048, (const float*)(ws + WS_LRS), 1.0f / (H8U_SCALE * W1_SCALE)};
            pg8::gemm_phase<pg8::MoeProb<1024, true, 3>, pg8::EpiSwiglu, MOE_ALIGN>(F.lds, P, E);
            } AFTER(pb + 6);
        }
        if (PHM(11) && RUN(pb + 7)) { for (int rep_ = 0; rep_ < REPS(11); ++rep_) { if (rep_) xcd_barrier(bar);
            if (!(PHM(10) && RUN(pb + 6))) compute_toff(F, cnt);
            pg8::MoeProb<1024, false, 1> P{ws + WS_ACT, ws + WS_W2 + (size_t)i * NEXP * 1024 * 1024, (size_t)1024 * 1024, (const int*)(ws + WS_LIST), cnt, F.misc + MI_TOFF, 4, F.G, F.vcu};
            pg8::EpiBias E{(void*)(ws + WS_Y), a.moe_b2 + (size_t)i * NEXP * 1024, 1.0f / (W2_SCALE * ACT8_SCALE)};
            pg8::gemm_phase<pg8::MoeProb<1024, false, 1>, pg8::EpiBias, MOE_ALIGN>(F.lds, P, E);
            } AFTER(pb + 7);
        }
        if (PHM(12) && RUN(pb + 8)) {
            if (!(PHM(10) && RUN(pb + 6))) compute_toff(F, cnt);
            const float* gain = (i == DEPTH - 1) ? nullptr : ((i & 1) == 0 ? a.ret_norm + (size_t)jl * DM : a.diff_norm + (size_t)(jl + 1) * DM);
            if (REPS(12) == 2) { tc_phase(F, a, i == DEPTH - 1, gain, (i & 1) == 0 ? (RET_FP8 != 0) : (QKV_FP8 != 0), true); xcd_barrier(bar); }
            tc_phase(F, a, i == DEPTH - 1, gain, (i & 1) == 0 ? (RET_FP8 != 0) : (QKV_FP8 != 0));
            AFTER(pb + 8);
        }
    }
#undef RUN
#undef AFTER
}

#ifndef MK_PER_PHASE
#define MK_PER_PHASE 0
#endif
extern "C" void kernel_launch(void* const* d_in, const int* in_sizes, int n_in, void* d_out, int out_size, void* d_ws, size_t ws_size, hipStream_t stream) {
    static int grid = 0;
    if (grid == 0) {
        if (n_in != 23 || in_sizes[0] != NTOK * DM || out_size != NTOK * DM || ws_size < WS_END) { fprintf(stderr, "kernel_launch: unexpected shapes (n_in %d, in0 %d, out %d, ws %zu); nothing launched\n", n_in, n_in > 0 ? in_sizes[0] : -1, out_size, ws_size); grid = -1; return; }
        int dev = 0, cus = 0, per_cu = 0;
        if (hipGetDevice(&dev) != hipSuccess || hipDeviceGetAttribute(&cus, hipDeviceAttributeMultiprocessorCount, dev) != hipSuccess) { fprintf(stderr, "kernel_launch: device query failed\n"); grid = -1; return; }
        if (hipFuncSetAttribute((const void*)fwd_kernel, hipFuncAttributeMaxDynamicSharedMemorySize, LDS_BYTES) != hipSuccess) { fprintf(stderr, "kernel_launch: hipFuncSetAttribute failed\n"); grid = -1; return; }
        if (hipOccupancyMaxActiveBlocksPerMultiprocessor(&per_cu, (const void*)fwd_kernel, 512, LDS_BYTES) != hipSuccess || per_cu < 1) fprintf(stderr, "kernel_launch: note: occupancy query reports %d workgroups per CU\n", per_cu);
        (void)hipGetLastError();
        grid = cus;
    }
    if (grid < 0) return;
    if (hipMemsetAsync((char*)d_ws + WS_CTL, 0, CTL_ZERO_BYTES, stream) != hipSuccess) { fprintf(stderr, "kernel_launch: memset failed\n"); return; }
    Args a{};
    const float** ap = (const float**)&a;
    for (int i = 0; i < 23; ++i) ap[i] = (const float*)d_in[i];
    a.out = (float*)d_out; a.ws = (unsigned char*)d_ws;
#if MK_PER_PHASE
    for (int p = 0; p < N_PHASES; ++p) {
        if (p > 0) { const int i = (p - 1) / 9, k = (p - 1) % 9; if ((i & 1) == 0 && (k == 1 || k == 3)) continue; }
        a.ph_lo = p; a.ph_hi = p + 1;
        hipLaunchKernelGGL(fwd_kernel, dim3(grid), dim3(512), LDS_BYTES, stream, a);
    }
#else
    a.ph_lo = 0; a.ph_hi = N_PHASES;
    hipLaunchKernelGGL(fwd_kernel, dim3(grid), dim3(512), LDS_BYTES, stream, a);
#endif
    const hipError_t le = hipPeekAtLastError();
    if (le != hipSuccess) fprintf(stderr, "kernel_launch: launch failed: %s\n", hipGetErrorName(le));
}
```

```cpp
#include <hip/hip_runtime.h>
#include <cstdio>
#include <cstdint>

#define GAS __attribute__((address_space(1)))
#define LAS __attribute__((address_space(3)))
typedef unsigned short bf16;
typedef unsigned v4u __attribute__((ext_vector_type(4)));
typedef unsigned v2u __attribute__((ext_vector_type(2)));
typedef float f32x4 __attribute__((ext_vector_type(4)));
typedef float f32x2 __attribute__((ext_vector_type(2)));
typedef float f32x16 __attribute__((ext_vector_type(16)));
typedef short bf16x8 __attribute__((ext_vector_type(8)));
typedef short s16x4 __attribute__((ext_vector_type(4)));
typedef __bf16 bf16x2_t __attribute__((ext_vector_type(2)));
typedef GAS unsigned gu32;

constexpr int NTOK = 65536, DM = 1024, SEQ = 4096, NBATCH = 16, DEPTH = 4;
constexpr int NEXP = 32, TOPK = 4, FF = 1024;
constexpr int RET_VW = 2048;
constexpr float NORM_EPS = 1e-5f;
constexpr float LOG2E = 1.4426950408889634f;

__device__ __forceinline__ unsigned cvtpk(float lo, float hi) { f32x2 v = {lo, hi}; bf16x2_t b = __builtin_convertvector(v, bf16x2_t); return __builtin_bit_cast(unsigned, b); }
__device__ __forceinline__ float bflo(unsigned u) { return __uint_as_float(u << 16); }
__device__ __forceinline__ float bfhi(unsigned u) { return __uint_as_float(u & 0xffff0000u); }
extern __shared__ __attribute__((aligned(16))) unsigned char lds_raw[];
constexpr int WTAB_BYTES = 147456 + 4 * 192;
__device__ __forceinline__ int lane_now() { int l; asm volatile("v_mbcnt_lo_u32_b32 %0, -1, 0\n\tv_mbcnt_hi_u32_b32 %0, -1, %0" : "=v"(l)); return l; }
__device__ __forceinline__ unsigned hw_wave_slot() { return (unsigned)__builtin_amdgcn_s_getreg((5 << 11) | 4) & 63u; }
__device__ __forceinline__ int opaque_tid() {
    const int w = __builtin_amdgcn_readfirstlane(*(const LAS int*)((LAS unsigned char*)lds_raw + WTAB_BYTES + 4 * hw_wave_slot()));
    int t = w * 64 + lane_now(); asm volatile("" : "+v"(t)); return t; }
__device__ __forceinline__ float shfl_xor_(float v, int m, int lane) { return __uint_as_float((unsigned)__builtin_amdgcn_ds_bpermute((lane ^ m) << 2, (int)__float_as_uint(v))); }
__device__ __forceinline__ float shfl_idx_(float v, int idx) { return __uint_as_float((unsigned)__builtin_amdgcn_ds_bpermute(idx << 2, (int)__float_as_uint(v))); }
template <class T> __device__ __forceinline__ T* opaque_ptr(T* p) { asm volatile("" : "+s"(p)); return p; }
__device__ __forceinline__ float wave_sum(float v) {
    const int l_ = lane_now();
#pragma unroll
    for (int o = 1; o < 64; o <<= 1) v += shfl_xor_(v, o, l_);
    return v;
}

namespace pg8 {
constexpr int BM = 256, BK = 64, HALF = 128, HTB = HALF * BK * 2  , STAGE_BYTES = 8 * HTB;

__host__ __device__ __forceinline__ int lds_byte(int r, int c) { const int st = (r >> 4) * 2 + (c >> 5), rr = r & 15, cc = c & 31, ob = rr * 64 + cc * 2; return st * 1024 + (ob ^ (((ob >> 9) & 1) << 5)); }
__host__ __device__ __forceinline__ void stage_rc(int b, int& R, int& C) { const int st = b / 1024, sb = b % 1024, swz = sb ^ (((sb >> 9) & 1) << 5); R = (st >> 1) * 16 + swz / 64; C = (st & 1) * 32 + (swz % 64) / 2; }
__host__ __device__ __forceinline__ int perm32(int rho) { const int n = rho >> 4, i = rho & 15; return 8 * (i >> 2) + 4 * n + (i & 3); }

typedef int v8i __attribute__((ext_vector_type(8)));
__device__ __forceinline__ v8i cat16(bf16x8 a, bf16x8 b) { const v4u x = __builtin_bit_cast(v4u, a), y = __builtin_bit_cast(v4u, b); return (v8i){(int)x.x, (int)x.y, (int)x.z, (int)x.w, (int)y.x, (int)y.y, (int)y.z, (int)y.w}; }
__device__ __forceinline__ void mfma_fp8_acc(f32x4& c, v8i a, v8i b, int sc1) {
    asm volatile("v_mfma_scale_f32_16x16x128_f8f6f4 %0, %1, %2, %0, %3, %3 op_sel_hi:[0,0,0]" : "+v"(c) : "v"(a), "v"(b), "v"(sc1));
}
constexpr int TEXP_REL = 8192 - 64;
constexpr int LISTPARK_OFF = 147456 + 4096;
constexpr int PARK_OFF = 147456 + 12288;
__device__ __forceinline__ void glds4(const GAS void* gsrc, unsigned lds_dst) { unsigned keep;
    asm volatile("s_mov_b32 %0, m0\n\ts_mov_b32 m0, %2\n\ts_nop 0\n\tglobal_load_lds_dword %1, off\n\ts_mov_b32 m0, %0" : "=&s"(keep) : "v"(gsrc), "s"(lds_dst) : "memory"); }
struct Unit { int pm, pn, e, lt; };

__device__ __forceinline__ void order_map(long L, int nN, int& pm, int& pn) {
    const int grp = (int)(L >> 5), w = (int)(L & 31), ncg = nN >> 2;
    pm = (grp / ncg) * 8 + (w & 7); pn = (grp % ncg) * 4 + (w >> 3);
}

template <int K_, int BMODE_, bool FP8_ = false> struct DenseProb {
    static constexpr int K = K_, BMODE = BMODE_, PB = FP8_ ? K_ : 2 * K_; static constexpr bool GATHER = false, FP8 = FP8_;
    const void* A; const void* Bt; int nM, nN, G, c;
    __device__ __forceinline__ bool next(int i, Unit& u) const {
        const long L = (long)i * G + c; if (L >= (long)nM * nN) return false;
        order_map(L, nN, u.pm, u.pn); u.e = 0; u.lt = 0; return true; }
    __device__ __forceinline__ const char* a_base(const Unit& u) const { return (const char*)A + (size_t)u.pm * ((size_t)BM * PB); }
    __device__ __forceinline__ const char* b_base(const Unit& u) const { return (const char*)Bt + (size_t)u.pn * ((size_t)BM * PB); }
    template <int NH> __device__ __forceinline__ void a_rows(const Unit&, int, unsigned (&)[NH][2]) const {}
    __device__ __forceinline__ void pre_rows(const Unit&, int, int, unsigned) const {}
    template <int NH> __device__ __forceinline__ void a_rows_lds(const Unit&, unsigned, unsigned (&)[NH][2], const LAS int*) const {}
};
template <int K_, bool GATHER_, int BMODE_> struct MoeProb {
    static constexpr int K = K_, BMODE = BMODE_, PB = K_; static constexpr bool GATHER = GATHER_, FP8 = true;
    const unsigned char* A; const unsigned char* Bt; size_t bstride;
    const int* list; const int* cnt; const LAS int* toff; int nN, G, c;
    __device__ __forceinline__ bool next(int i, Unit& u) const {
        const int TM = toff[32], TM8 = (TM + 7) & ~7; const long L = (long)i * G + c; if (L >= (long)TM8 * nN) return false;
        int gm, pn; order_map(L, nN, gm, pn); if (gm >= TM) gm = TM - 1;
        const int e = __builtin_amdgcn_readfirstlane((int)((const LAS unsigned char*)toff + TEXP_REL)[gm]);
        u.pm = gm; u.pn = pn; u.e = e; u.lt = gm - toff[e]; return true; }
    __device__ __forceinline__ const char* a_base(const Unit& u) const { return GATHER ? (const char*)A : (const char*)A + (size_t)u.pm * ((size_t)BM * PB); }
    __device__ __forceinline__ const char* b_base(const Unit& u) const { return (const char*)Bt + (size_t)u.e * bstride + (size_t)u.pn * ((size_t)BM * PB); }
    __device__ __forceinline__ void pre_rows(const Unit& u, int wid, int lane, unsigned park) const {
        if (wid < 4) glds4((const GAS void*)(list + (size_t)u.e * NTOK + u.lt * 256 + 64 * wid + lane), park + 256u * (unsigned)wid); }
    template <int NH> __device__ __forceinline__ void a_rows_lds(const Unit& u, unsigned c2, unsigned (&off)[NH][2], const LAS int* park) const {
        const int n = toff[128 + u.e] - u.lt * 256;
        int R, C; stage_rc(opaque_tid() * 16, R, C);
#pragma unroll
        for (int h = 0; h < NH; ++h)
#pragma unroll
            for (int i = 0; i < 2; ++i) { const int idx = h * 128 + i * 64 + R; int tok = park[idx]; if (idx >= n) tok = 0;
                off[h][i] = (unsigned)tok * (unsigned)PB + c2; }
    }
    template <int NH> __device__ __forceinline__ void a_rows(const Unit& u, int tid, unsigned (&off)[NH][2]) const {
        const int n = ((const GAS int*)cnt)[u.e]; const GAS int* le = (const GAS int*)list + (size_t)u.e * NTOK;
        asm volatile("" : "+v"(tid));
#pragma unroll
        for (int h = 0; h < NH; ++h)
#pragma unroll
            for (int i = 0; i < 2; ++i) { int R, C; stage_rc(tid * 16 + i * 8192, R, C); int pos = u.lt * 256 + h * 128 + R; if (pos >= n) pos = 0; const int tok = le[pos]; off[h][i] = (unsigned)tok * (unsigned)PB + (unsigned)(C * 2); }
    }
};

template <class Prob, class Epi, bool ALIGN_EPI>
__device__ __forceinline__ void gemm_phase(LAS unsigned char* lds, const Prob& S, const Epi& E) {
    const int tid = opaque_tid(), wid = __builtin_amdgcn_readfirstlane(tid >> 6), lane = tid & 63, wr = wid >> 2, wc = wid & 3, fr = lane & 15, fq = lane >> 4;
    constexpr int PB = Prob::PB, nt = PB / 128;
    constexpr int NH = Prob::GATHER ? 2 : 1;
    unsigned voffB[2], coffA[NH][2], noffA[NH][2];
    constexpr size_t kstep = (size_t)(BK * 2);
    constexpr size_t hstepA = (size_t)HALF * PB;
    constexpr size_t hstepB = (size_t)(Prob::BMODE == 2 ? 32 : (Prob::BMODE == 3 ? 8 : HALF)) * PB;
#pragma unroll
    for (int i = 0; i < 2; ++i) { int R, C; stage_rc(tid * 16 + i * 8192, R, C);
        const int Rb = Prob::BMODE == 0 ? R : (Prob::BMODE == 1 ? ((R & ~31) + perm32(R & 31)) : (Prob::BMODE == 2 ? (64 * (R >> 5) + perm32(R & 31)) : (64 * (R >> 5) + 16 * ((R & 15) >> 2) + 4 * ((R >> 4) & 1) + (R & 3))));
        voffB[i] = (unsigned)(Rb * PB + C * 2);
#pragma unroll
        for (int h = 0; h < NH; ++h) { coffA[h][i] = (unsigned)(R * PB + C * 2); noffA[h][i] = coffA[h][i]; } }
    const unsigned ldsw = (unsigned)wid * 1024u;
    const int aoff = lds_byte(wr * 64 + fr, fq * 8), boff = lds_byte(wc * 32 + fr, fq * 8);
#define PG8_SA(b, h) (((b) * 2 + (h)) * HTB)
#define PG8_SB(b, h) ((4 + (b) * 2 + (h)) * HTB)
#define PG8_STAGE_A(bufoff, gbase, h, arr) do { _Pragma("unroll") for (int _i = 0; _i < 2; ++_i) \
        __builtin_amdgcn_global_load_lds((const unsigned*)((const char*)(gbase) + (Prob::GATHER ? (size_t)0 : (size_t)(h) * hstepA) + (arr)[Prob::GATHER ? (h) : 0][_i]), (LAS unsigned*)(lds + (bufoff) + ldsw + _i * 8192), 16, 0, 0); } while (0)
#define PG8_STAGE(bufoff, gbase, voff) do { _Pragma("unroll") for (int _i = 0; _i < 2; ++_i) \
        __builtin_amdgcn_global_load_lds((const unsigned*)((const char*)(gbase) + (voff)[_i]), (LAS unsigned*)(lds + (bufoff) + ldsw + _i * 8192), 16, 0, 0); } while (0)
#define PG8_LDA(dst, b, h) do { _Pragma("unroll") for (int m = 0; m < 4; ++m) _Pragma("unroll") for (int k = 0; k < 2; ++k) dst[m][k] = *(const LAS bf16x8*)(lds + PG8_SA(b, h) + aoff + m * 2048 + k * 1024); } while (0)
#define PG8_LDB(dst, b, h) do { _Pragma("unroll") for (int n = 0; n < 2; ++n) _Pragma("unroll") for (int k = 0; k < 2; ++k) dst[n][k] = *(const LAS bf16x8*)(lds + PG8_SB(b, h) + boff + n * 2048 + k * 1024); } while (0)
#define PG8_MMA(ai, bj, At, Bt) do { __builtin_amdgcn_s_setprio(1); _Pragma("unroll") for (int m = 0; m < 4; ++m) _Pragma("unroll") for (int n = 0; n < 2; ++n) { \
        if constexpr (Prob::FP8) mfma_fp8_acc(acc[ai][bj][m][n], cat16(Bt[n][0], Bt[n][1]), cat16(At[m][0], At[m][1]), sc1); \
        else { _Pragma("unroll") for (int k = 0; k < 2; ++k) acc[ai][bj][m][n] = __builtin_amdgcn_mfma_f32_16x16x32_bf16(Bt[n][k], At[m][k], acc[ai][bj][m][n], 0, 0, 0); } } \
        __builtin_amdgcn_s_setprio(0); } while (0)
#define PG8_WAIT_V(n) asm volatile("s_waitcnt vmcnt(" #n ")" ::: "memory")
#define PG8_WAIT_L(n) asm volatile("s_waitcnt lgkmcnt(" #n ")" ::: "memory")
#define PG8_BAR __builtin_amdgcn_s_barrier()
#define PG8_SCHED __builtin_amdgcn_sched_barrier(0)
    int sc1 = 0x7f7f7f7f; asm volatile("" : "+v"(sc1));
    Unit cur, nxt; int ui = 0;
    if (!S.next(0, cur)) return;
    if constexpr (Epi::PARK) E.pre(cur, wid, lane, (unsigned)__builtin_amdgcn_readfirstlane((unsigned)(size_t)(lds + PARK_OFF)));
    f32x4 acc[2][2][4][2];
#pragma unroll
    for (int a = 0; a < 2; ++a)
#pragma unroll
        for (int b = 0; b < 2; ++b)
#pragma unroll
            for (int m = 0; m < 4; ++m)
#pragma unroll
                for (int n = 0; n < 2; ++n) acc[a][b][m][n] = (f32x4){0.f, 0.f, 0.f, 0.f};
    bf16x8 At[4][2], B0[2][2], B1[2][2];
    const char* cA = S.a_base(cur); const char* cB = S.b_base(cur);
    if constexpr (Prob::GATHER) { S.template a_rows<NH>(cur, tid, coffA); PG8_WAIT_V(0); }
    PG8_STAGE(PG8_SB(0, 0), cB, voffB); PG8_STAGE(PG8_SB(0, 1), cB + hstepB, voffB); PG8_STAGE_A(PG8_SA(0, 0), cA, 0, coffA); PG8_STAGE_A(PG8_SA(0, 1), cA, 1, coffA);
    if (wr == 1) PG8_BAR;
    PG8_WAIT_V(2); PG8_BAR;
    PG8_STAGE(PG8_SB(1, 0), cB + kstep, voffB); PG8_STAGE_A(PG8_SA(1, 0), cA + kstep, 0, coffA); PG8_STAGE(PG8_SB(1, 1), cB + hstepB + kstep, voffB);
    PG8_WAIT_V(6); PG8_BAR;
    for (;;) {
        const bool has_next = S.next(ui + 1, nxt);
        const char* nA = has_next ? S.a_base(nxt) : cA; const char* nB = has_next ? S.b_base(nxt) : cB;
        if constexpr (Prob::GATHER) {
            { Unit n2; if (S.next(ui + 2, n2)) S.pre_rows(n2, wid, lane, (unsigned)__builtin_amdgcn_readfirstlane((unsigned)(size_t)(lds + LISTPARK_OFF + ((ui + 2) % 3) * 1024))); }
            if (has_next) {
                if (ui == 0) { S.template a_rows<NH>(nxt, tid, noffA); PG8_WAIT_V(0); }
                else S.template a_rows_lds<NH>(nxt, coffA[0][0] & (unsigned)(PB - 1), noffA, (const LAS int*)(lds + LISTPARK_OFF + ((ui + 1) % 3) * 1024)); }
            else {
#pragma unroll
                for (int h = 0; h < NH; ++h)
#pragma unroll
                    for (int i = 0; i < 2; ++i) noffA[h][i] = coffA[h][i]; }
        }
#pragma unroll 1
        for (int t = 0; t < nt; t += 2) {
            const bool last = (t == nt - 2);
#ifdef DRAIN_PROBE
            if (Prob::FP8 && t == nt / 2) PG8_WAIT_V(0);
#endif
            const char* a1 = cA + (size_t)(t + 1) * kstep;
            const char* a2 = last ? nA : cA + (size_t)(t + 2) * kstep; const char* b2 = last ? nB : cB + (size_t)(t + 2) * kstep;
            const char* a3 = a2 + kstep; const char* b3 = b2 + kstep;
            PG8_LDB(B0, 0, 0); PG8_LDB(B1, 0, 1); PG8_SCHED; PG8_LDA(At, 0, 0); PG8_STAGE_A(PG8_SA(1, 1), a1, 1, coffA);
            if constexpr (Prob::GATHER) { if (last) {
#pragma unroll
                for (int h = 0; h < NH; ++h)
#pragma unroll
                    for (int i = 0; i < 2; ++i) coffA[h][i] = noffA[h][i]; } }
            PG8_WAIT_V(8); PG8_WAIT_L(0); PG8_BAR; PG8_MMA(0, 0, At, B0); PG8_MMA(0, 1, At, B1); PG8_BAR; PG8_SCHED;
            PG8_LDA(At, 0, 1); PG8_STAGE(PG8_SB(0, 0), b2, voffB); PG8_STAGE(PG8_SB(0, 1), b2 + hstepB, voffB); PG8_STAGE_A(PG8_SA(0, 0), a2, 0, coffA);
            PG8_WAIT_V(8); PG8_WAIT_L(0); PG8_BAR; PG8_MMA(1, 0, At, B0); PG8_MMA(1, 1, At, B1); PG8_BAR; PG8_SCHED;
            PG8_LDB(B0, 1, 0); PG8_LDB(B1, 1, 1); PG8_SCHED; PG8_LDA(At, 1, 0); PG8_STAGE_A(PG8_SA(0, 1), a2, 1, coffA);
            PG8_WAIT_V(8); PG8_WAIT_L(0); PG8_BAR; PG8_MMA(0, 0, At, B0); PG8_MMA(0, 1, At, B1); PG8_BAR; PG8_SCHED;
            PG8_LDA(At, 1, 1); PG8_STAGE(PG8_SB(1, 0), b3, voffB); PG8_STAGE(PG8_SB(1, 1), b3 + hstepB, voffB); PG8_STAGE_A(PG8_SA(1, 0), a3, 0, coffA);
            PG8_WAIT_V(8); PG8_WAIT_L(0); PG8_BAR; PG8_MMA(1, 0, At, B0); PG8_MMA(1, 1, At, B1); PG8_BAR; PG8_SCHED;
        }
        if constexpr (Prob::FP8) asm volatile("s_nop 15\n\ts_nop 15" ::: "memory");
        if constexpr (ALIGN_EPI) { if (wr == 0) PG8_BAR; }
        if constexpr (Epi::PARK) E(acc, cur, wr, wc, fr, fq, (const LAS float*)(lds + PARK_OFF + (ui & 1) * 2048)); else E(acc, cur, wr, wc, fr, fq);
        if (!has_next) break;
#pragma unroll
        for (int a = 0; a < 2; ++a)
#pragma unroll
            for (int b = 0; b < 2; ++b)
#pragma unroll
                for (int m = 0; m < 4; ++m)
#pragma unroll
                    for (int n = 0; n < 2; ++n) acc[a][b][m][n] = (f32x4){0.f, 0.f, 0.f, 0.f};
        cur = nxt; cA = nA; cB = nB; ++ui;
        if constexpr (Epi::PARK) E.pre(cur, wid, lane, (unsigned)__builtin_amdgcn_readfirstlane((unsigned)(size_t)(lds + PARK_OFF + (ui & 1) * 2048)));
        if constexpr (Prob::GATHER) {
#pragma unroll
            for (int h = 0; h < NH; ++h)
#pragma unroll
                for (int i = 0; i < 2; ++i) coffA[h][i] = noffA[h][i]; }
        if constexpr (ALIGN_EPI) { if (wr == 1) PG8_BAR; }
    }
    PG8_WAIT_V(0);
    if constexpr (!ALIGN_EPI) { if (wr == 0) PG8_BAR; }
    PG8_BAR;
#undef PG8_SA
#undef PG8_SB
#undef PG8_STAGE
#undef PG8_STAGE_A
#undef PG8_LDA
#undef PG8_LDB
#undef PG8_MMA
#undef PG8_WAIT_V
#undef PG8_WAIT_L
#undef PG8_BAR
#undef PG8_SCHED
}
}

#ifndef Y_FP8
#define Y_FP8 1
#endif
constexpr float Y8_SCALE = 16.0f, ACT8_SCALE = 4.0f;
namespace pg8 {
struct EpiQKV {
    static constexpr bool PARK = true;
    bf16* Qo; bf16* Ko; bf16* Vo; const float* qg; const float* kg; float sc;
    __device__ __forceinline__ void pre(const Unit& u, int wid, int lane, unsigned park) const {
        if (wid == 0 && u.pn < 8) glds4((const GAS void*)((u.pn < 4 ? qg : kg) + lane), park); }
    __device__ __forceinline__ void operator()(const f32x4 (&acc)[2][2][4][2], const Unit& u, int wr, int wc, int fr, int fq, const LAS float* park) const {
        const int sec = u.pn >> 2; const int colt = (u.pn & 3) * 256 + wc * 64 + 8 * fq;
        bf16* base = Qo + (size_t)sec * ((size_t)NTOK * DM);
        const int row0 = u.pm * 256 + wr * 64 + fr;
        const float sc = sec == 0 ? (0.125f * LOG2E) : 1.f;
        f32x4 gv[2][2];
#pragma unroll
        for (int bj = 0; bj < 2; ++bj)
#pragma unroll
            for (int n = 0; n < 2; ++n) gv[bj][n] = sec < 2 ? *(const LAS f32x4*)(park + 32 * bj + 8 * fq + 4 * n) : (f32x4){1.f, 1.f, 1.f, 1.f};
#pragma unroll
        for (int ai = 0; ai < 2; ++ai)
#pragma unroll
            for (int m = 0; m < 4; ++m) {
                float rs = 1.f;
                if (sec < 2) { float ss = 0.f;
#pragma unroll
                    for (int bj = 0; bj < 2; ++bj)
#pragma unroll
                        for (int n = 0; n < 2; ++n) { const f32x4 x = acc[ai][bj][m][n]; ss += (x[0] * x[0] + x[1] * x[1]) + (x[2] * x[2] + x[3] * x[3]); }
                    { const int l_ = lane_now(); ss += shfl_xor_(ss, 16, l_); ss += shfl_xor_(ss, 32, l_); }
                    rs = __builtin_amdgcn_rsqf(ss * (sc * sc * (1.0f / 64.0f)) + NORM_EPS) * sc; }
                bf16* rowp = base + (size_t)(row0 + ai * 128 + m * 16) * DM + colt;
#pragma unroll
                for (int bj = 0; bj < 2; ++bj) { f32x4 g0 = (f32x4){sc, sc, sc, sc}, g1 = g0;
                    if (sec < 2) { g0 = gv[bj][0] * (rs * sc); g1 = gv[bj][1] * (rs * sc); }
                    const f32x4 v0 = acc[ai][bj][m][0] * g0, v1 = acc[ai][bj][m][1] * g1;
                    v4u w; w.x = cvtpk(v0[0], v0[1]); w.y = cvtpk(v0[2], v0[3]); w.z = cvtpk(v1[0], v1[1]); w.w = cvtpk(v1[2], v1[3]);
                    *(GAS v4u*)(rowp + 32 * bj) = w; }
                asm volatile("" ::: "memory");
            }
    }
};
struct EpiRetIn {
    static constexpr bool PARK = false;
    bf16 *Qo, *KFo, *KBo, *Vo, *Go; const float* lgf; const float* lgb; float sc;
    __device__ __forceinline__ void operator()(const f32x4 (&acc)[2][2][4][2], const Unit& u, int wr, int wc, int fr, int fq) const {
        const int pn = u.pn; const int row0 = u.pm * 256 + wr * 64 + fr; const int cw = wc * 32 + 8 * fq;
        if (pn >= 4 && pn < 8) {
            const int hd = pn - 4; const float lf = ((const GAS float*)lgf)[hd], lb = ((const GAS float*)lgb)[hd];
            float zf[2], zb[2];
#pragma unroll
            for (int mm = 0; mm < 2; ++mm) { const float i32 = (float)(16 * mm + fr); zf[mm] = __expf(lf * (31.0f - i32)) * 0.0625f * sc; zb[mm] = __expf(lb * i32) * 0.0625f * sc; }
#pragma unroll
            for (int ai = 0; ai < 2; ++ai)
#pragma unroll
                for (int m = 0; m < 4; ++m) { const size_t off = (size_t)(row0 + ai * 128 + m * 16) * 1024 + hd * 256 + cw;
#pragma unroll
                    for (int bj = 0; bj < 2; ++bj) { const f32x4 a0 = acc[ai][bj][m][0], a1 = acc[ai][bj][m][1]; const float f = zf[m & 1], b = zb[m & 1];
                        v4u w; w.x = cvtpk(a0[0] * f, a0[1] * f); w.y = cvtpk(a0[2] * f, a0[3] * f); w.z = cvtpk(a1[0] * f, a1[1] * f); w.w = cvtpk(a1[2] * f, a1[3] * f);
                        *(GAS v4u*)(KFo + off + 128 * bj) = w;
                        w.x = cvtpk(a0[0] * b, a0[1] * b); w.y = cvtpk(a0[2] * b, a0[3] * b); w.z = cvtpk(a1[0] * b, a1[1] * b); w.w = cvtpk(a1[2] * b, a1[3] * b);
                        *(GAS v4u*)(KBo + off + 128 * bj) = w; } }
        } else {
            bf16* base; int ld, ct;
            if (pn < 4) { base = Qo; ld = 1024; ct = pn; } else if (pn < 16) { base = Vo; ld = 2048; ct = pn - 8; } else { base = Go; ld = 2048; ct = pn - 16; }
#pragma unroll
            for (int ai = 0; ai < 2; ++ai)
#pragma unroll
                for (int m = 0; m < 4; ++m) { bf16* rowp = base + (size_t)(row0 + ai * 128 + m * 16) * ld + ct * 256 + cw;
#pragma unroll
                    for (int bj = 0; bj < 2; ++bj) { const f32x4 a0 = acc[ai][bj][m][0] * sc, a1 = acc[ai][bj][m][1] * sc;
                        v4u w; w.x = cvtpk(a0[0], a0[1]); w.y = cvtpk(a0[2], a0[3]); w.z = cvtpk(a1[0], a1[1]); w.w = cvtpk(a1[2], a1[3]);
                        *(GAS v4u*)(rowp + 128 * bj) = w; } }
        }
    }
};
struct EpiResid {
    static constexpr bool PARK = false;
    const float* resid; float* out;
    __device__ __forceinline__ void operator()(const f32x4 (&acc)[2][2][4][2], const Unit& u, int wr, int wc, int fr, int fq) const {
        const int row0 = u.pm * 256 + wr * 64 + fr, col0 = u.pn * 256 + wc * 32 + 4 * fq;
#pragma unroll
        for (int ai = 0; ai < 2; ++ai)
#pragma unroll
            for (int m = 0; m < 4; ++m) { const size_t off = (size_t)(row0 + ai * 128 + m * 16) * DM + col0;
                f32x4 r[2][2];
#pragma unroll
                for (int bj = 0; bj < 2; ++bj)
#pragma unroll
                    for (int n = 0; n < 2; ++n) r[bj][n] = *(const GAS f32x4*)(resid + off + bj * 128 + n * 16);
#pragma unroll
                for (int bj = 0; bj < 2; ++bj)
#pragma unroll
                    for (int n = 0; n < 2; ++n) *(GAS f32x4*)(out + off + bj * 128 + n * 16) = r[bj][n] + acc[ai][bj][m][n];
                if (m & 1) asm volatile("" ::: "memory"); }
    }
};
struct EpiDelta {
    static constexpr bool PARK = false;
    bf16* d; float sc;
    __device__ __forceinline__ void operator()(const f32x4 (&acc)[2][2][4][2], const Unit& u, int wr, int wc, int fr, int fq) const {
        const int row0 = u.pm * 256 + wr * 64 + fr, c0 = u.pn * 256 + wc * 32 + 8 * fq;
        v4u old[2][4][2];
#pragma unroll
        for (int ai = 0; ai < 2; ++ai)
#pragma unroll
            for (int m = 0; m < 4; ++m)
#pragma unroll
                for (int bj = 0; bj < 2; ++bj) old[ai][m][bj] = *(const GAS v4u*)(d + (size_t)(row0 + ai * 128 + m * 16) * DM + c0 + 128 * bj);
#pragma unroll
        for (int ai = 0; ai < 2; ++ai) {
#pragma unroll
            for (int m = 0; m < 4; ++m) { bf16* rowp = d + (size_t)(row0 + ai * 128 + m * 16) * DM + c0;
#pragma unroll
                for (int bj = 0; bj < 2; ++bj) { const f32x4 a0 = acc[ai][bj][m][0] * sc, a1 = acc[ai][bj][m][1] * sc; const v4u o = old[ai][m][bj];
                    v4u w; w.x = cvtpk(a0[0] + bflo(o.x), a0[1] + bfhi(o.x)); w.y = cvtpk(a0[2] + bflo(o.y), a0[3] + bfhi(o.y)); w.z = cvtpk(a1[0] + bflo(o.z), a1[1] + bfhi(o.z)); w.w = cvtpk(a1[2] + bflo(o.w), a1[3] + bfhi(o.w));
                    *(GAS v4u*)(rowp + 128 * bj) = w; } } }
    }
};
__device__ __forceinline__ float swiglu1(float g, float l) {
    g = fminf(g, 7.0f); l = fminf(fmaxf(l, -7.0f), 7.0f);
    const float s = __builtin_amdgcn_rcpf(1.0f + __builtin_amdgcn_exp2f(-1.702f * LOG2E * g));
    return g * s * (l + 1.0f);
}
constexpr float SWC = -1.702f * LOG2E;
__device__ __forceinline__ float swiglu_c(float cg, float l) {
    cg = fmaxf(cg, 7.0f * SWC); l = fminf(fmaxf(l, -7.0f), 7.0f);
    const float s = __builtin_amdgcn_rcpf(1.0f + __builtin_amdgcn_exp2f(cg));
    return (cg * s) * fmaf(l, ACT8_SCALE / SWC, ACT8_SCALE / SWC);
}
__device__ __forceinline__ f32x2 swiglu_c2(f32x2 cg, f32x2 l) {
    cg = (f32x2){fmaxf(cg.x, 7.0f * SWC), fmaxf(cg.y, 7.0f * SWC)}; l = (f32x2){fminf(fmaxf(l.x, -7.0f), 7.0f), fminf(fmaxf(l.y, -7.0f), 7.0f)};
    const f32x2 d = (f32x2){__builtin_amdgcn_exp2f(cg.x), __builtin_amdgcn_exp2f(cg.y)} + (f32x2){1.0f, 1.0f};
    const f32x2 s = (f32x2){__builtin_amdgcn_rcpf(d.x), __builtin_amdgcn_rcpf(d.y)};
    constexpr float K = ACT8_SCALE / SWC;
    return (cg * s) * __builtin_elementwise_fma(l, (f32x2){K, K}, (f32x2){K, K});
}
__device__ __forceinline__ unsigned pack_fp8x4(float a, float b, float c, float d) { int w = 0; w = __builtin_amdgcn_cvt_pk_fp8_f32(a, b, w, false); w = __builtin_amdgcn_cvt_pk_fp8_f32(c, d, w, true); return (unsigned)w; }
struct EpiSwiglu {
    static constexpr bool PARK = true;
    unsigned char* act; const float* b1; const float* lrs; float sc;
    __device__ __forceinline__ void pre(const Unit& u, int wid, int lane, unsigned park) const {
        if (wid < 4) glds4((const GAS void*)(b1 + (size_t)u.e * 2048 + u.pn * 256 + 64 * wid + lane), park + 256u * (unsigned)wid);
        else glds4((const GAS void*)(lrs + (size_t)u.e * NTOK + u.lt * 256 + 64 * (wid - 4) + lane), park + 1024u + 256u * (unsigned)(wid - 4)); }
    __device__ __forceinline__ void operator()(const f32x4 (&acc)[2][2][4][2], const Unit& u, int wr, int wc, int fr, int fq, const LAS float* park) const {
        const int row0 = u.pm * 256 + wr * 64 + fr; const int c0 = u.pn * 256 + wc * 64 + 16 * fq;
        f32x4 bv[2][2];
#pragma unroll
        for (int bj = 0; bj < 2; ++bj)
#pragma unroll
            for (int n = 0; n < 2; ++n) bv[bj][n] = *(const LAS f32x4*)(park + wc * 64 + 16 * fq + 8 * bj + 4 * n) * (f32x4){SWC, 1.f, SWC, 1.f};
        float rsv[2][4];
        { const LAS float* rp = park + 256 + wr * 64 + fr;
#pragma unroll
          for (int ai = 0; ai < 2; ++ai)
#pragma unroll
              for (int m = 0; m < 4; ++m) rsv[ai][m] = sc * rp[ai * 128 + m * 16]; }
#pragma unroll
        for (int ai = 0; ai < 2; ++ai)
#pragma unroll
            for (int m = 0; m < 4; ++m) { unsigned char* rowp = act + (size_t)(row0 + ai * 128 + m * 16) * FF + (c0 >> 1);
                const float rs = rsv[ai][m]; const f32x2 rs2 = (f32x2){rs * SWC, rs};
                v2u w;
#pragma unroll
                for (int bj = 0; bj < 2; ++bj) { const f32x4 a0 = acc[ai][bj][m][0], a1 = acc[ai][bj][m][1]; const f32x4 b0 = bv[bj][0], b1_ = bv[bj][1];
                    const f32x2 p0 = __builtin_elementwise_fma((f32x2){a0[0], a0[1]}, rs2, (f32x2){b0[0], b0[1]}), p1 = __builtin_elementwise_fma((f32x2){a0[2], a0[3]}, rs2, (f32x2){b0[2], b0[3]});
                    const f32x2 p2 = __builtin_elementwise_fma((f32x2){a1[0], a1[1]}, rs2, (f32x2){b1_[0], b1_[1]}), p3 = __builtin_elementwise_fma((f32x2){a1[2], a1[3]}, rs2, (f32x2){b1_[2], b1_[3]});
                    const f32x2 o01 = swiglu_c2((f32x2){p0.x, p1.x}, (f32x2){p0.y, p1.y}), o23 = swiglu_c2((f32x2){p2.x, p3.x}, (f32x2){p2.y, p3.y});
                    const unsigned p = pack_fp8x4(o01.x, o01.y, o23.x, o23.y);
                    if (bj == 0) w.x = p; else w.y = p; }
                *(GAS v2u*)rowp = w; }
    }
};
struct EpiBias {
    static constexpr bool PARK = true;
    void* y; const float* b2; float sc;
    __device__ __forceinline__ void pre(const Unit& u, int wid, int lane, unsigned park) const {
        if (wid < 4) glds4((const GAS void*)(b2 + (size_t)u.e * 1024 + u.pn * 256 + 64 * wid + lane), park + 256u * (unsigned)wid); }
    __device__ __forceinline__ void operator()(const f32x4 (&acc)[2][2][4][2], const Unit& u, int wr, int wc, int fr, int fq, const LAS float* park) const {
        const int row0 = u.pm * 256 + wr * 64 + fr; const int c0 = u.pn * 256 + wc * 32 + 8 * fq;
        f32x4 bv[2][2];
#pragma unroll
        for (int bj = 0; bj < 2; ++bj)
#pragma unroll
            for (int n = 0; n < 2; ++n) bv[bj][n] = *(const LAS f32x4*)(park + wc * 32 + 8 * fq + bj * 128 + 4 * n) * (Y_FP8 ? Y8_SCALE : 1.0f);
        const float scy = sc * (Y_FP8 ? Y8_SCALE : 1.0f);
#pragma unroll
        for (int ai = 0; ai < 2; ++ai)
#pragma unroll
            for (int m = 0; m < 4; ++m) { const size_t ro = (size_t)(row0 + ai * 128 + m * 16) * DM + c0;
#pragma unroll
                for (int bj = 0; bj < 2; ++bj) { const f32x4 v0 = acc[ai][bj][m][0] * scy + bv[bj][0], v1 = acc[ai][bj][m][1] * scy + bv[bj][1];
                    if (Y_FP8) { v2u w; w.x = pack_fp8x4(v0[0], v0[1], v0[2], v0[3]); w.y = pack_fp8x4(v1[0], v1[1], v1[2], v1[3]);
                        *(GAS v2u*)((unsigned char*)y + ro + 128 * bj) = w; }
                    else { v4u w; w.x = cvtpk(v0[0], v0[1]); w.y = cvtpk(v0[2], v0[3]); w.z = cvtpk(v1[0], v1[1]); w.w = cvtpk(v1[2], v1[3]);
                        *(GAS v4u*)((bf16*)y + ro + 128 * bj) = w; } } }
    }
};
}

constexpr size_t MiB = 1u << 20;
constexpr size_t WS_CTL = 0, CTL_ZERO_BYTES = 1 * MiB;
constexpr size_t WS_WDI = 2 * MiB, WS_WDO = 14 * MiB, WS_WRI = 18 * MiB, WS_WRO = 42 * MiB, WS_W1 = 50 * MiB, WS_W2 = 562 * MiB;
constexpr size_t WS_HB = 818 * MiB;
constexpr size_t WS_PROJ = 946 * MiB;
constexpr size_t WS_AO = 1842 * MiB;
constexpr size_t WS_ROF = 1970 * MiB, WS_ROB = 2226 * MiB, WS_RGO = 2482 * MiB, WS_RP = 2738 * MiB;
constexpr size_t WS_ACT = 2754 * MiB, WS_Y = 3282 * MiB;
constexpr float H8U_SCALE = 4.0f;
constexpr float AO8_SCALE = 8.0f, WDO_SCALE = 128.0f;
constexpr float H8_SCALE = 8.0f, W1_SCALE = 64.0f, W2_SCALE = 128.0f, WRI_SCALE = 64.0f, WRO_SCALE = 128.0f, GO8_SCALE = 4.0f;
constexpr size_t WS_LIST = 3810 * MiB, WS_TSLOT = 3818 * MiB, WS_TGATE = 3819 * MiB, WS_HB8 = 3820 * MiB, WS_XB = 3884 * MiB, WS_WRT = 4012 * MiB, WS_LRS = 4013 * MiB, WS_END = 4021 * MiB;
constexpr int WRP = 1032;
constexpr int CW_BAR = 4096, CW_CNT = 8192;
constexpr int RING_BYTES = 147456, MISC_OFF = RING_BYTES, LDS_BYTES = 163840;

#define RLX_AGENT __ATOMIC_RELAXED, __HIP_MEMORY_SCOPE_AGENT
#define XB_TMO      128
#define XB_XCNT(j)  (256  + 64 * (j))
#define XB_XSUB(j)  (1280 + 64 * (j))
#define XB_XGEN(j)  (2304 + 64 * (j))
#define XB_TOP      3328
#define XB_TOPGEN   3392
#define XCD_BAR_WORDS 3456
#define XB_SPIN_CAP (1u << 18)

__device__ __forceinline__ unsigned xb_ld(unsigned* p)              { return __hip_atomic_load(p, __ATOMIC_RELAXED, __HIP_MEMORY_SCOPE_AGENT); }
__device__ __forceinline__ unsigned xb_add(unsigned* p, unsigned v) { return __hip_atomic_fetch_add(p, v, __ATOMIC_RELAXED, __HIP_MEMORY_SCOPE_AGENT); }
__device__ __forceinline__ unsigned xb_xcc_id() { return (unsigned)__builtin_amdgcn_s_getreg((3 << 11) | 20) & 0xFu; }
#define XB_SPIN(cond, bar) do { unsigned _sp = 0; while (cond) { __builtin_amdgcn_s_sleep(1); \
    if ((++_sp & 255u) == 0u) { if (xb_ld(&(bar)[XB_TMO])) break; if (_sp > XB_SPIN_CAP) { atomicAdd(&(bar)[XB_TMO], 1u); break; } } } } while (0)

struct XcdBarrier {
    unsigned* bar; unsigned x;
    volatile LAS unsigned* st;
};

__device__ __forceinline__ XcdBarrier xcd_barrier_post(unsigned* bar, volatile LAS unsigned* st) {
    XcdBarrier b; b.bar = bar; b.x = xb_xcc_id(); b.st = st;
    if (opaque_tid() == 0) (void)xb_add(&bar[XB_XCNT(b.x)], 1u);
    return b;
}
__device__ __forceinline__ void xcd_barrier_complete(unsigned* bar, unsigned x, unsigned& nloc, unsigned& nx) {
    const unsigned G = gridDim.x * gridDim.y * gridDim.z;
    unsigned sum, cnt, mine, sp = 0u;
    for (;;) {
        sum = 0u; cnt = 0u; mine = 0u;
#pragma unroll
        for (unsigned j = 0; j < 16; ++j) { const unsigned c = xb_ld(&bar[XB_XCNT(j)]); sum += c; cnt += (c > 0u) ? 1u : 0u; mine = (j == x) ? c : mine; }
        if (sum == G) break;
        __builtin_amdgcn_s_sleep(1);
        if ((++sp & 255u) == 0u) { if (xb_ld(&bar[XB_TMO])) break; if (sp > XB_SPIN_CAP) { atomicAdd(&bar[XB_TMO], 1u); break; } }
    }
    nloc = mine > 0u ? mine : 1u; nx = cnt > 0u ? cnt : 1u;
}

__device__ __forceinline__ void xcd_barrier(const XcdBarrier& b) {
    asm volatile("s_waitcnt vmcnt(0)" ::: "memory");
    __syncthreads();
    if (opaque_tid() == 0) {
        unsigned* bar = b.bar;
        __builtin_amdgcn_s_waitcnt(0);
        unsigned nloc = b.st[0], nx = b.st[1];
        if (nloc == 0u) { xcd_barrier_complete(bar, b.x, nloc, nx); b.st[0] = nloc; b.st[1] = nx; }
        const unsigned old = xb_add(&bar[XB_XSUB(b.x)], 1u);
        const unsigned gen = old / nloc;
        if (old + 1u == (gen + 1u) * nloc) {
            __builtin_amdgcn_fence(__ATOMIC_RELEASE, "agent");
            asm volatile("s_waitcnt vmcnt(0)" ::: "memory");
            const unsigned og = xb_add(&bar[XB_TOP], 1u);
            const unsigned tg = og / nx;
            if (og + 1u == (tg + 1u) * nx) xb_add(&bar[XB_TOPGEN], 1u);
            else XB_SPIN(xb_ld(&bar[XB_TOPGEN]) == tg, bar);
            __builtin_amdgcn_fence(__ATOMIC_ACQUIRE, "agent");
            xb_add(&bar[XB_XGEN(b.x)], 1u);
            asm volatile("s_waitcnt vmcnt(0)" ::: "memory");
        } else {
            XB_SPIN(xb_ld(&bar[XB_XGEN(b.x)]) == gen, bar);
            __builtin_amdgcn_fence(__ATOMIC_ACQUIRE, "agent");
            asm volatile("s_waitcnt vmcnt(0)" ::: "memory");
        }
    }
    __syncthreads();
}

#ifndef ATT_OUT_FP8
#define ATT_OUT_FP8 1
#endif
namespace att {
typedef short v4i16_t __attribute__((ext_vector_type(4)));
constexpr int KSLOT = 8192, VSLOT = 16384;
constexpr int NSLOT = 3;
constexpr int L_K = 0, L_V = NSLOT * KSLOT, L_WS = L_V + NSLOT * VSLOT, L_OST = L_WS + 8 * 512, L_END = L_OST + 8 * 8192;
__device__ __forceinline__ int crow(int r, int hi) { return (r & 3) + 8 * (r >> 2) + 4 * hi; }
__device__ __forceinline__ s16x4 vtr(const LAS char* p) { return __builtin_bit_cast(s16x4, __builtin_amdgcn_ds_read_tr16_b64_v4i16((LAS v4i16_t*)p)); }
__device__ __forceinline__ bf16x8 cat8(s16x4 lo, s16x4 hi) { return (bf16x8){lo[0], lo[1], lo[2], lo[3], hi[0], hi[1], hi[2], hi[3]}; }
__device__ __forceinline__ bf16x8 pack8(const f32x16& p, int s) {
    v4u w; w.x = cvtpk(p[8 * s], p[8 * s + 1]); w.y = cvtpk(p[8 * s + 2], p[8 * s + 3]); w.z = cvtpk(p[8 * s + 4], p[8 * s + 5]); w.w = cvtpk(p[8 * s + 6], p[8 * s + 7]);
    return __builtin_bit_cast(bf16x8, w);
}
__device__ __forceinline__ void glds16(const GAS void* gsrc, unsigned lds_dst) { unsigned keep;
    asm volatile("s_mov_b32 %0, m0\n\ts_mov_b32 m0, %2\n\ts_nop 0\n\tglobal_load_lds_dwordx4 %1, off\n\ts_mov_b32 m0, %0" : "=&s"(keep) : "v"(gsrc), "s"(lds_dst) : "memory"); }
struct AttnArgs { const bf16* Q; const bf16* K; const bf16* V; bf16* O; float lam; const float* subg; float oscale; float qkb; };

__device__ __forceinline__ int tile_seq(int it, int q4, int nl) { return it < 4 ? q4 + it : (it < 4 + nl ? q4 + 3 - it : q4 + it - nl); }

__device__ __forceinline__ void attn_unit(int b, int h, int qb, const AttnArgs& A, LAS char* shm) {
    const int tid = opaque_tid(), lane = tid & 63, r32 = lane & 31, hi = lane >> 5; const int wid = __builtin_amdgcn_readfirstlane(tid >> 6);
    const size_t rowbase = (size_t)b * SEQ;
    const int qw0 = qb * 256 + wid * 32, q4 = qb * 4, qh = qw0 >> 5;
    const float fi = (float)(qw0 + r32);
    const float slope = __builtin_amdgcn_exp2f(-(float)(h + 1)), sl2 = slope * LOG2E;
    constexpr float SKIP_T = 32.0f;
    const int W = (int)fminf((2.0f * A.qkb + SKIP_T) / slope, 8192.0f) + 1;
    const int jlo = max(0, (qb * 256 - W) >> 6), jhi = min(SEQ / 64 - 1, (qb * 256 + 255 + W) >> 6);
    const int NT = jhi - jlo + 1, nl = qb * 4 - jlo;
    const float B2 = A.qkb * LOG2E; const bool fixref = (2.0f * B2 < 100.0f);
    const bf16x8 ones = (bf16x8){0x3F80, 0x3F80, 0x3F80, 0x3F80, 0x3F80, 0x3F80, 0x3F80, 0x3F80};
    const float sl2h = sl2 * (float)(4 * hi);
    LAS float* wsf = (LAS float*)(shm + L_WS) + wid * 128;
#pragma unroll 1
    for (int c = 0; c < 2; ++c) {
        bf16x8 qr[4];
        { const bf16* qu = A.Q + (rowbase + qw0) * DM + h * 128 + c * 64; const unsigned ql = (unsigned)(r32 * DM + hi * 8);
#pragma unroll
          for (int d0 = 0; d0 < 4; ++d0) qr[d0] = __builtin_nontemporal_load((const GAS bf16x8*)(qu + (ql + d0 * 16)));
#pragma unroll
          for (int d0 = 0; d0 < 4; ++d0) asm volatile("" : "+v"(qr[d0])); }
        float m = fixref ? B2 : 0.f; f32x16 o[4], ol;
#pragma unroll
        for (int r = 0; r < 16; ++r) ol[r] = 0.f;
#pragma unroll
        for (int d0 = 0; d0 < 4; ++d0)
#pragma unroll
            for (int r = 0; r < 16; ++r) o[d0][r] = 0.f;
        const bf16* kgu = A.K + rowbase * DM + h * 128 + c * 64 + wid * 8;
        const bf16* vgu = A.V + (rowbase + 16 * (wid & 3)) * DM + h * 128 + 32 * (wid >> 2);
        const unsigned kl = (unsigned)(lane * DM), vl = (unsigned)((lane >> 2) * DM + 8 * (lane & 3));
        const unsigned lds0 = (unsigned)(size_t)shm;
        const unsigned kw = lds0 + L_K + wid * 1024, vw = lds0 + L_V + wid * 1024;
#define ATT_DMA(tile, slot) do { const size_t to_ = (size_t)(tile) * 64 * DM; \
            glds16((const GAS void*)(kgu + to_ + kl), (unsigned)__builtin_amdgcn_readfirstlane(kw + (slot) * KSLOT)); \
            glds16((const GAS void*)(vgu + to_ + vl), (unsigned)__builtin_amdgcn_readfirstlane(vw + (slot) * VSLOT)); \
            glds16((const GAS void*)(vgu + to_ + 64 + vl), (unsigned)__builtin_amdgcn_readfirstlane(vw + (slot) * VSLOT + 8192)); } while (0)
        ATT_DMA(tile_seq(0, q4, nl), 0); ATT_DMA(tile_seq(1, q4, nl), 1);
        asm volatile("s_waitcnt vmcnt(0)\n\ts_barrier" ::: "memory");
        int slot = 0;
#define ATT_QK(PN, jt, hb_, sl_) do { const int kh_ = 2 * (jt) + (hb_); const LAS char* kb_ = shm + L_K + (sl_) * KSLOT + hi * 1024 + r32 * 16 + (hb_) * 512; \
            bf16x8 kf_[4]; _Pragma("unroll") for (int d0 = 0; d0 < 4; ++d0) kf_[d0] = *(const LAS bf16x8*)(kb_ + d0 * 2048); \
            if (kh_ == qh) { const float x0 = (float)(32 * kh_) - fi + (float)(4 * hi); \
                _Pragma("unroll") for (int r = 0; r < 16; ++r) { const float x = x0 + (float)((r & 3) + 8 * (r >> 2)); PN[r] = -sl2 * fabsf(x) - m; } \
            } else if (kh_ < qh) { const float base = sl2 * ((float)(32 * kh_) - fi) - m + sl2h; \
                _Pragma("unroll") for (int r = 0; r < 16; ++r) PN[r] = fmaf(sl2, (float)((r & 3) + 8 * (r >> 2)), base); \
            } else { const float base = sl2 * (fi - (float)(32 * kh_)) - m - sl2h; \
                _Pragma("unroll") for (int r = 0; r < 16; ++r) PN[r] = fmaf(-sl2, (float)((r & 3) + 8 * (r >> 2)), base); } \
            __builtin_amdgcn_sched_barrier(0); \
            _Pragma("unroll") for (int d0 = 0; d0 < 4; ++d0) PN = __builtin_amdgcn_mfma_f32_32x32x16_bf16(kf_[d0], qr[d0], PN, 0, 0, 0); \
            __builtin_amdgcn_sched_barrier(0); } while (0)
        f32x16 pn;
#if defined(ATT_DUP) && (ATT_DUP & 8)
        bf16x8 zfrag_ = (bf16x8){0, 0, 0, 0, 0, 0, 0, 0}; asm volatile("" : "+v"(zfrag_));
#endif
        ATT_QK(pn, tile_seq(0, q4, nl), 0, 0);
#pragma unroll 1
        for (int it = 0; it < NT; ++it) {
            const int j = tile_seq(it, q4, nl), buf = slot, nslot = slot == NSLOT - 1 ? 0 : slot + 1;
            if (it + 2 < NT) { const int s2 = slot >= 1 ? slot - 1 : slot + 2; ATT_DMA(tile_seq(it + 2, q4, nl), s2);
#if defined(ATT_DUP) && (ATT_DUP & 2)
                ATT_DMA(tile_seq(it + 2, q4, nl), s2);
#endif
            }
            const LAS char* vp = shm + L_V + buf * VSLOT + ((lane >> 4) & 1) * 32 + (lane & 3) * 8 + (4 * hi + ((lane & 15) >> 2)) * 64;
#pragma unroll
            for (int hb = 0; hb < 2; ++hb) {
                f32x16 p = pn;
                if (hb == 0) ATT_QK(pn, j, 1, buf);
                else if (it + 1 < NT) ATT_QK(pn, tile_seq(it + 1, q4, nl), 0, nslot);
                s16x4 vk0[8], vk1[8];
#define ATT_VLDK(dst, ks) do { _Pragma("unroll") for (int d0 = 0; d0 < 4; ++d0) { dst[2 * d0] = vtr(vp + d0 * 4096 + (2 * hb + (ks)) * 1024); dst[2 * d0 + 1] = vtr(vp + d0 * 4096 + (2 * hb + (ks)) * 1024 + 512); } } while (0)
                ATT_VLDK(vk0, 0);
                __builtin_amdgcn_sched_barrier(0);
                if (!fixref) {
                    float rm = fmaxf(p[0], p[1]);
#pragma unroll
                    for (int r = 2; r < 16; ++r) rm = fmaxf(rm, p[r]);
                    rm = fmaxf(rm, shfl_xor_(rm, 32, lane_now()));
                    const bool first = (it == 0 && hb == 0);
                    if (first || __any(rm > 6.0f)) {
                        const float dl = first ? rm : fmaxf(rm, 0.f);
                        m += dl;
#pragma unroll
                        for (int r = 0; r < 16; ++r) { p[r] -= dl; pn[r] -= dl; }
                        if (!first) {
                            const float f = __builtin_amdgcn_exp2f(-dl);
                            if (hi == 0) wsf[r32] = f;
#pragma unroll
                            for (int g = 0; g < 4; ++g) { const f32x4 t = *(const LAS f32x4*)(wsf + 8 * g + 4 * hi);
                                ol[4 * g] *= t[0]; ol[4 * g + 1] *= t[1]; ol[4 * g + 2] *= t[2]; ol[4 * g + 3] *= t[3];
#pragma unroll
                                for (int d0 = 0; d0 < 4; ++d0) { o[d0][4 * g] *= t[0]; o[d0][4 * g + 1] *= t[1]; o[d0][4 * g + 2] *= t[2]; o[d0][4 * g + 3] *= t[3]; } }
                        }
                    }
                }
#define EX2(i) do { p[i] = __builtin_amdgcn_exp2f(p[i]); p[(i) + 1] = __builtin_amdgcn_exp2f(p[(i) + 1]); } while (0)
#define SB() __builtin_amdgcn_sched_barrier(0)
#pragma unroll
                for (int r = 0; r < 8; ++r) p[r] = __builtin_amdgcn_exp2f(p[r]);
                const bf16x8 pw0 = pack8(p, 0);
                SB();
                ATT_VLDK(vk1, 1);
                SB();
                __builtin_amdgcn_s_setprio(1);
                ol = __builtin_amdgcn_mfma_f32_32x32x16_bf16(pw0, ones, ol, 0, 0, 0); EX2(8); SB();
                o[0] = __builtin_amdgcn_mfma_f32_32x32x16_bf16(pw0, cat8(vk0[0], vk0[1]), o[0], 0, 0, 0); EX2(10); SB();
                o[1] = __builtin_amdgcn_mfma_f32_32x32x16_bf16(pw0, cat8(vk0[2], vk0[3]), o[1], 0, 0, 0); EX2(12); SB();
                o[2] = __builtin_amdgcn_mfma_f32_32x32x16_bf16(pw0, cat8(vk0[4], vk0[5]), o[2], 0, 0, 0); EX2(14); SB();
                o[3] = __builtin_amdgcn_mfma_f32_32x32x16_bf16(pw0, cat8(vk0[6], vk0[7]), o[3], 0, 0, 0);
                const bf16x8 pw1 = pack8(p, 1);
                SB();
                ol = __builtin_amdgcn_mfma_f32_32x32x16_bf16(pw1, ones, ol, 0, 0, 0);
#pragma unroll
                for (int d0 = 0; d0 < 4; ++d0) o[d0] = __builtin_amdgcn_mfma_f32_32x32x16_bf16(pw1, cat8(vk1[2 * d0], vk1[2 * d0 + 1]), o[d0], 0, 0, 0);
                __builtin_amdgcn_s_setprio(0);
                SB();
#undef EX2
#undef SB
#undef ATT_VLDK
            }
            asm volatile("s_waitcnt vmcnt(0) lgkmcnt(0)\n\ts_barrier" ::: "memory");
            slot = nslot;
        }
#undef ATT_QK
#undef ATT_DMA
        int le = lane; asm volatile("" : "+v"(le));
        const int r32e = le & 31, hie = le >> 5;
        float rl[16];
#pragma unroll
        for (int r = 0; r < 16; ++r) rl[r] = __builtin_amdgcn_rcpf(ol[r]);
        LAS unsigned* svl = (LAS unsigned*)(shm + L_OST + wid * 8192) + le;
        if (c == 0) {
#pragma unroll
            for (int d0 = 0; d0 < 4; ++d0)
#pragma unroll
                for (int r2 = 0; r2 < 8; ++r2) svl[(d0 * 8 + r2) * 64] = cvtpk(o[d0][2 * r2] * rl[2 * r2], o[d0][2 * r2 + 1] * rl[2 * r2 + 1]);
        } else {
            float ss[16];
#pragma unroll
            for (int r = 0; r < 16; ++r) ss[r] = 0.f;
#pragma unroll
            for (int d0 = 0; d0 < 4; ++d0)
#pragma unroll
                for (int r2 = 0; r2 < 8; ++r2) { const unsigned svv = svl[(d0 * 8 + r2) * 64];
                    const float a = bflo(svv) - A.lam * o[d0][2 * r2] * rl[2 * r2], bq = bfhi(svv) - A.lam * o[d0][2 * r2 + 1] * rl[2 * r2 + 1];
                    o[d0][2 * r2] = a; o[d0][2 * r2 + 1] = bq; ss[2 * r2] += a * a; ss[2 * r2 + 1] += bq * bq; }
#pragma unroll
            for (int x = 1; x < 32; x <<= 1) { const int pa = (le ^ x) << 2;
#pragma unroll
                for (int r = 0; r < 16; ++r) ss[r] += __uint_as_float(__builtin_amdgcn_ds_bpermute(pa, __float_as_uint(ss[r]))); }
#pragma unroll
            for (int r = 0; r < 16; ++r) ss[r] = __builtin_amdgcn_rsqf(ss[r] * (1.0f / 128.0f) + NORM_EPS);
            asm volatile("s_waitcnt lgkmcnt(0)" ::: "memory");
#if ATT_OUT_FP8
            LAS unsigned char* stg = (LAS unsigned char*)(shm + L_OST + wid * 8192);
#pragma unroll
            for (int d0 = 0; d0 < 4; ++d0) { const float sg = ((const GAS float*)A.subg)[r32e + 32 * d0] * A.oscale * AO8_SCALE;
#pragma unroll
                for (int r = 0; r < 16; ++r) { const float v_ = o[d0][r] * ss[r] * sg; stg[crow(r, hie) * 128 + d0 * 32 + r32e] = (unsigned char)(__builtin_amdgcn_cvt_pk_fp8_f32(v_, v_, 0, false) & 0xff); } }
            unsigned char* Ow = (unsigned char*)A.O + (rowbase + qw0) * DM + h * 128; const unsigned olo = (unsigned)((le >> 3) * DM + (le & 7) * 16);
#pragma unroll
            for (int i = 0; i < 4; ++i) { const int row = i * 8 + (le >> 3), ch = le & 7; const v4u v = *(const LAS v4u*)(stg + row * 128 + ch * 16); *(GAS v4u*)(Ow + (olo + (unsigned)(i * 8 * DM))) = v; }
#else
            LAS bf16* stg = (LAS bf16*)(shm + L_OST + wid * 8192);
#pragma unroll
            for (int d0 = 0; d0 < 4; ++d0) { const float sg = ((const GAS float*)A.subg)[r32e + 32 * d0] * A.oscale;
#pragma unroll
                for (int r = 0; r < 16; ++r) stg[crow(r, hie) * 128 + d0 * 32 + r32e] = (bf16)(cvtpk(o[d0][r] * ss[r] * sg, 0.f) & 0xffffu); }
            bf16* Ow = A.O + (rowbase + qw0) * DM + h * 128; const unsigned olo = (unsigned)((le >> 4) * DM + (le & 15) * 8);
#pragma unroll
            for (int i = 0; i < 8; ++i) { const int row = i * 4 + (le >> 4), ch = le & 15; const v4u v = *(const LAS v4u*)(stg + row * 128 + ch * 8); *(GAS v4u*)(Ow + (olo + (unsigned)(i * 4 * DM))) = v; }
#endif
        }
    }
}
}

namespace ret {
using att::crow; using att::vtr; using att::cat8; using att::pack8;
constexpr int QPITCH = 520, PPITCH = 72;
constexpr int L_Q = 0, L_KT = 32 * QPITCH, L_VT = L_KT + 16384, L_PT = L_VT + 16384, BUFB = L_PT + 32 * PPITCH;

__device__ __forceinline__ void rp_unit(int b, int h, int sc, const bf16* RQ, const bf16* RKF, const bf16* RKB, bf16* RP, float lgf, float lgb) {
    const int lane = opaque_tid() & 63, r32 = lane & 31, hi = lane >> 5;
    const size_t tb = (size_t)b * SEQ + 32 * sc;
    const size_t ro = (tb + r32) * 1024 + h * 256 + 8 * hi;
    f32x16 pf;
#pragma unroll
    for (int r = 0; r < 16; ++r) pf[r] = 0.f;
#pragma unroll
    for (int ks = 0; ks < 16; ++ks) {
        const bf16x8 a = *(const GAS bf16x8*)(RQ + ro + 16 * ks), kf = *(const GAS bf16x8*)(RKF + ro + 16 * ks);
        pf = __builtin_amdgcn_mfma_f32_32x32x16_bf16(a, kf, pf, 0, 0, 0);
    }
    const float fj = (float)r32, upj = lgf * (fj - 31.0f) + lgb * fj;
#pragma unroll
    for (int r = 0; r < 16; ++r) { const int i = crow(r, hi); const float fi = (float)i;
        const float v = pf[r] * __expf((r32 <= i) ? lgf * (fi - 31.0f) : upj - lgb * fi);
        ((GAS bf16*)RP)[(tb + i) * 128 + h * 32 + r32] = (bf16)(cvtpk(v, 0.f) & 0xffffu); }
}

struct ChainArgs { const bf16* RQ; const bf16* RK; const bf16* RV; const bf16* RP; bf16* OUT; float lg; };

__device__ __forceinline__ void chain_unit(int b, int h, int dir, int vs, const ChainArgs& A, LAS char* shm) {
    const int tid = opaque_tid(), lane = tid & 63, r32 = lane & 31, hi = lane >> 5; const int wid = __builtin_amdgcn_readfirstlane(tid >> 6);
    const float decay = __expf(A.lg * 32.0f);
    const float xiB = __expf(A.lg * (dir == 0 ? (float)(4 * hi + 1) : (float)(32 - 4 * hi))), xiU = __expf(dir == 0 ? A.lg : -A.lg), xiW = __expf(dir == 0 ? 8.0f * A.lg : -8.0f * A.lg);
    f32x16 S[8];
#pragma unroll
    for (int db = 0; db < 8; ++db)
#pragma unroll
        for (int r = 0; r < 16; ++r) S[db][r] = 0.f;
    const int qrow = tid >> 4, qch = tid & 15;
    const bf16* qg = A.RQ + ((size_t)b * SEQ + qrow) * 1024 + h * 256 + qch * 8;
    const int srow = lane >> 2, sch = lane & 3;
    const bf16* kg = A.RK + ((size_t)b * SEQ + 16 * (wid & 1) + srow) * 1024 + h * 256 + 32 * (wid >> 1) + 8 * sch;
    const bf16* vg = A.RV + ((size_t)b * SEQ + 16 * (wid & 1) + srow) * 2048 + h * 512 + vs * 256 + 32 * (wid >> 1) + 8 * sch;
    const bf16* pg = A.RP + ((size_t)b * SEQ + (tid >> 2)) * 128 + h * 32 + (tid & 3) * 8;
    v4u q0, q1, k0, k1, v0, v1, pp;
    pp = (v4u){0u, 0u, 0u, 0u};
#define RET_LOAD(sc) do { const size_t t_ = (size_t)(sc) * 32; \
        q0 = *(const GAS v4u*)(qg + t_ * 1024); q1 = *(const GAS v4u*)(qg + t_ * 1024 + 128); \
        k0 = *(const GAS v4u*)(kg + t_ * 1024); k1 = *(const GAS v4u*)(kg + t_ * 1024 + 128); \
        v0 = __builtin_nontemporal_load((const GAS v4u*)(vg + t_ * 2048)); v1 = __builtin_nontemporal_load((const GAS v4u*)(vg + t_ * 2048 + 128)); \
        if (dir == 0 && tid < 128) pp = *(const GAS v4u*)(pg + t_ * 128); } while (0)
#define RET_STORE(bufp) do { LAS char* b_ = (bufp); \
        *(LAS v2u*)(b_ + L_Q + qrow * QPITCH + qch * 16) = (v2u){q0.x, q0.y}; *(LAS v2u*)(b_ + L_Q + qrow * QPITCH + qch * 16 + 8) = (v2u){q0.z, q0.w}; \
        *(LAS v2u*)(b_ + L_Q + qrow * QPITCH + qch * 16 + 256) = (v2u){q1.x, q1.y}; *(LAS v2u*)(b_ + L_Q + qrow * QPITCH + qch * 16 + 264) = (v2u){q1.z, q1.w}; \
        *(LAS v4u*)(b_ + L_KT + wid * 1024 + lane * 16) = k0; *(LAS v4u*)(b_ + L_KT + (wid + 8) * 1024 + lane * 16) = k1; \
        *(LAS v4u*)(b_ + L_VT + wid * 1024 + lane * 16) = v0; *(LAS v4u*)(b_ + L_VT + (wid + 8) * 1024 + lane * 16) = v1; \
        if (dir == 0 && tid < 128) { *(LAS v2u*)(b_ + L_PT + (tid >> 2) * PPITCH + (tid & 3) * 16) = (v2u){pp.x, pp.y}; *(LAS v2u*)(b_ + L_PT + (tid >> 2) * PPITCH + (tid & 3) * 16 + 8) = (v2u){pp.z, pp.w}; } } while (0)
    RET_LOAD(dir == 0 ? 0 : 127);
    RET_STORE(shm);
    __syncthreads();
    const int tro = ((lane >> 4) & 1) * 32 + (lane & 3) * 8 + (4 * hi + ((lane & 15) >> 2)) * 64;
#pragma unroll 1
    for (int s = 0; s < 128; ++s) {
        const int sc = dir == 0 ? s : 127 - s;
        LAS char* buf = shm + (s & 1) * BUFB;
        if (s + 1 < 128) RET_LOAD(dir == 0 ? s + 1 : 126 - s);
        f32x16 out;
#pragma unroll
        for (int r = 0; r < 16; ++r) out[r] = 0.f;
        const LAS char* qb = buf + L_Q + r32 * QPITCH + 8 * hi;
#pragma unroll
        for (int db = 0; db < 8; ++db)
#pragma unroll
            for (int s2 = 0; s2 < 2; ++s2) {
                const bf16x8 sb = pack8(S[db], s2);
                const bf16x8 a = cat8(*(const LAS s16x4*)(qb + (32 * db + 16 * s2) * 2), *(const LAS s16x4*)(qb + (32 * db + 16 * s2) * 2 + 16));
                out = __builtin_amdgcn_mfma_f32_32x32x16_bf16(a, sb, out, 0, 0, 0);
            }
        { float f8 = xiB;
#pragma unroll
          for (int g4 = 0; g4 < 4; ++g4) { float fz = f8;
#pragma unroll
              for (int z = 0; z < 4; ++z) { out[4 * g4 + z] *= fz; fz *= xiU; }
              f8 *= xiW; } }
        bf16x8 vf[2];
#pragma unroll
        for (int ks = 0; ks < 2; ++ks) vf[ks] = cat8(vtr(buf + L_VT + wid * 2048 + ks * 1024 + tro), vtr(buf + L_VT + wid * 2048 + ks * 1024 + 512 + tro));
        if (dir == 0) {
            const LAS char* pb = buf + L_PT + r32 * PPITCH + 8 * hi;
#pragma unroll
            for (int ks = 0; ks < 2; ++ks) {
                const bf16x8 a = cat8(*(const LAS s16x4*)(pb + 32 * ks), *(const LAS s16x4*)(pb + 32 * ks + 16));
                out = __builtin_amdgcn_mfma_f32_32x32x16_bf16(a, vf[ks], out, 0, 0, 0);
            }
        }
        { bf16* op = A.OUT + ((size_t)b * SEQ + (size_t)sc * 32) * 2048 + h * 512 + vs * 256 + 32 * wid + r32;
#pragma unroll
          for (int r = 0; r < 16; ++r) ((GAS bf16*)op)[(size_t)crow(r, hi) * 2048] = (bf16)(cvtpk(out[r], 0.f) & 0xffffu); }
#pragma unroll
        for (int db = 0; db < 8; ++db) {
#pragma unroll
            for (int r = 0; r < 16; ++r) S[db][r] *= decay;
#pragma unroll
            for (int ks = 0; ks < 2; ++ks) {
                const bf16x8 a = cat8(vtr(buf + L_KT + db * 2048 + ks * 1024 + tro), vtr(buf + L_KT + db * 2048 + ks * 1024 + 512 + tro));
                S[db] = __builtin_amdgcn_mfma_f32_32x32x16_bf16(a, vf[ks], S[db], 0, 0, 0);
            }
        }
        if (s + 1 < 128) RET_STORE(shm + ((s + 1) & 1) * BUFB);
        __syncthreads();
    }
#undef RET_LOAD
#undef RET_STORE
}
}

struct Args {
    const float* x; const float* diff_norm; const float* diff_w_in; const float* diff_w_out;
    const float* lq1; const float* lk1; const float* lq2; const float* lk2; const float* qn; const float* kn; const float* subln;
    const float* ret_norm; const float* ret_w_in; const float* ret_w_out; const float* lgf; const float* lgb;
    const float* moe_norm; const float* moe_rw; const float* moe_rb; const float* moe_w1; const float* moe_b1; const float* moe_w2; const float* moe_b2;
    float* out; unsigned char* ws; int ph_lo, ph_hi;
};
struct Frame {
    LAS unsigned char* lds; LAS int* misc;
    int tid, lane, wave, vcu, G;
};
constexpr int MI_TOFF = 16, MI_LCNT = 80, MI_LBASE = 112, MI_WSCR = 256, MI_STR = 768, MI_STEP = 1024, MI_STG = 2048;

__device__ __forceinline__ void load_row(const float* xrow, int lane, f32x4 (&v)[4]) {
    const GAS f32x4* p = (const GAS f32x4*)xrow + lane;
#pragma unroll
    for (int j = 0; j < 4; ++j) v[j] = p[64 * j];
}
__device__ __forceinline__ void rms_row(const f32x4 (&v)[4], const f32x4 (&g)[4], f32x4 (&h)[4]) {
    float s = 0.f;
#pragma unroll
    for (int j = 0; j < 4; ++j) s += (v[j][0] * v[j][0] + v[j][1] * v[j][1]) + (v[j][2] * v[j][2] + v[j][3] * v[j][3]);
    const float rstd = 1.0f / sqrtf(wave_sum(s) * (1.0f / DM) + NORM_EPS);
#pragma unroll
    for (int j = 0; j < 4; ++j) h[j] = v[j] * rstd * g[j];
}
__device__ __forceinline__ void store_row_bf16(bf16* hrow, int lane, const f32x4 (&h)[4]) {
    GAS v2u* o = (GAS v2u*)hrow + lane;
#pragma unroll
    for (int j = 0; j < 4; ++j) { v2u w; w.x = cvtpk(h[j][0], h[j][1]); w.y = cvtpk(h[j][2], h[j][3]); o[64 * j] = w; }
}

__device__ __forceinline__ void transpose_item(const float* W, int K, int N, bf16* WT, LAS float* scr, int item, int lane) {
    const int nblk = N / 32, kb = item / nblk, nb = item % nblk, k0 = 64 * kb, n0 = 32 * nb;
#pragma unroll 8
    for (int i = 0; i < 32; ++i) { const int kk = 2 * i + (lane >> 5); scr[kk * 33 + (lane & 31)] = ((const GAS float*)W)[(size_t)(k0 + kk) * N + n0 + (lane & 31)]; }
    asm volatile("s_waitcnt lgkmcnt(0)" ::: "memory");
    const int c = lane & 7;
#pragma unroll
    for (int j = 0; j < 4; ++j) { const int n = (lane >> 3) + 8 * j; const LAS float* s = scr + (8 * c) * 33 + n;
        v4u o; o.x = cvtpk(s[0 * 33], s[1 * 33]); o.y = cvtpk(s[2 * 33], s[3 * 33]); o.z = cvtpk(s[4 * 33], s[5 * 33]); o.w = cvtpk(s[6 * 33], s[7 * 33]);
        *(GAS v4u*)(WT + (size_t)(n0 + n) * K + k0 + 8 * c) = o; }
    asm volatile("s_waitcnt lgkmcnt(0)" ::: "memory");
}
#ifndef QKV_FP8
#define QKV_FP8 0
#endif
#ifndef DO_FP8
#define DO_FP8 1
#endif
#ifndef RO_FP8
#define RO_FP8 1
#endif
#ifndef RET_FP8
#define RET_FP8 1
#endif
__device__ __forceinline__ void transpose_item_fp8(const float* W, int K, int N, unsigned char* WT, float scale, LAS float* scr, int item, int lane) {
    const int nblk = N / 32, kb = item / nblk, nb = item % nblk, k0 = 64 * kb, n0 = 32 * nb;
#pragma unroll 8
    for (int i = 0; i < 32; ++i) { const int kk = 2 * i + (lane >> 5); scr[kk * 33 + (lane & 31)] = ((const GAS float*)W)[(size_t)(k0 + kk) * N + n0 + (lane & 31)]; }
    asm volatile("s_waitcnt lgkmcnt(0)" ::: "memory");
    const int n = lane >> 1, kh = lane & 1; const LAS float* s = scr + (32 * kh) * 33 + n;
    v4u o[2];
#pragma unroll
    for (int q = 0; q < 2; ++q) { unsigned w[4];
#pragma unroll
        for (int z = 0; z < 4; ++z) { const LAS float* t = s + (16 * q + 4 * z) * 33; w[z] = pg8::pack_fp8x4(t[0] * scale, t[33] * scale, t[66] * scale, t[99] * scale); }
        o[q] = (v4u){w[0], w[1], w[2], w[3]}; }
    unsigned char* dst = WT + (size_t)(n0 + n) * K + k0 + 32 * kh;
    *(GAS v4u*)dst = o[0]; *(GAS v4u*)(dst + 16) = o[1];
    asm volatile("s_waitcnt lgkmcnt(0)" ::: "memory");
}
__device__ __forceinline__ Frame relaunder(const Frame& F0) { Frame F = F0; F.tid = opaque_tid(); F.lane = F.tid & 63; F.wave = __builtin_amdgcn_readfirstlane(F.tid >> 6); return F; }
struct ConvItem { const float* W; unsigned char* WT; int K, N, k0, n0; float scale; };
__device__ __forceinline__ ConvItem conv_decode(const Args& a, int r) {
    constexpr int I2 = 2 * 16 * 192, I3 = 2 * 32 * 32, I4 = 128 * 16 * 64;
    ConvItem c; int per, nblk;
    if (r < I2) { per = 16 * 192; const int mi = r / per; c.W = a.ret_w_in + (size_t)mi * 1024 * 6144; c.WT = a.ws + WS_WRI + (size_t)mi * 6144 * 1024; c.K = 1024; c.N = 6144; c.scale = WRI_SCALE; r -= mi * per; }
    else if ((r -= I2) < I3) { per = 32 * 32; const int mi = r / per; c.W = a.ret_w_out + (size_t)mi * 2048 * 1024; c.WT = a.ws + WS_WRO + (size_t)mi * 1024 * 2048; c.K = 2048; c.N = 1024; c.scale = WRO_SCALE; r -= mi * per; }
    else if ((r -= I3) < I4) { per = 16 * 64; const int mi = r / per; c.W = a.moe_w1 + (size_t)mi * 1024 * 2048; c.WT = a.ws + WS_W1 + (size_t)mi * 2048 * 1024; c.K = 1024; c.N = 2048; c.scale = W1_SCALE; r -= mi * per; }
    else { r -= I4; per = 16 * 32; const int mi = r / per; c.W = a.moe_w2 + (size_t)mi * 1024 * 1024; c.WT = a.ws + WS_W2 + (size_t)mi * 1024 * 1024; c.K = 1024; c.N = 1024; c.scale = W2_SCALE; r -= mi * per; }
    nblk = c.N / 32; c.k0 = 64 * (r / nblk); c.n0 = 32 * (r % nblk); return c;
}
__device__ __forceinline__ void conv_load(const ConvItem& c, int lane, f32x4 (&v)[8]) {
    const GAS float* p = (const GAS float*)c.W + (size_t)(c.k0 + 8 * (lane >> 3)) * c.N + c.n0 + 4 * (lane & 7);
#pragma unroll
    for (int i = 0; i < 8; ++i) v[i] = __builtin_nontemporal_load((const GAS f32x4*)(p + (size_t)i * c.N));
}
__device__ __forceinline__ void conv_finish(const ConvItem& c, int lane, const f32x4 (&v)[8]) {
    unsigned char* dst = c.WT + (size_t)(c.n0 + 4 * (lane & 7)) * c.K + c.k0 + 8 * (lane >> 3);
#pragma unroll
    for (int z = 0; z < 4; ++z) { v2u w;
        w.x = pg8::pack_fp8x4(v[0][z] * c.scale, v[1][z] * c.scale, v[2][z] * c.scale, v[3][z] * c.scale);
        w.y = pg8::pack_fp8x4(v[4][z] * c.scale, v[5][z] * c.scale, v[6][z] * c.scale, v[7][z] * c.scale);
        __builtin_nontemporal_store(w, (GAS v2u*)(dst + (size_t)z * c.K)); }
}
__device__ __forceinline__ void deferred_conversion(const Frame& F0, const Args& a) {
    const Frame F = relaunder(F0);
    const int gw = F.vcu * 8 + F.wave, NGW = F.G * 8;
    constexpr int NDEF = 2 * 16 * 192 + 2 * 32 * 32 + 128 * 16 * 64 + 128 * 16 * 32;
    if (gw >= NDEF) return;
    const int n = (NDEF - gw + NGW - 1) / NGW;
    f32x4 va[8], vb[8], vc[8], vd[8];
#define CV_ITEM(j_) conv_decode(a, gw + ((j_) < n ? (j_) : n - 1) * NGW)
    conv_load(CV_ITEM(0), F.lane, va); conv_load(CV_ITEM(1), F.lane, vb); conv_load(CV_ITEM(2), F.lane, vc); conv_load(CV_ITEM(3), F.lane, vd);
#pragma unroll 1
    for (int j = 0; j < n; j += 4) {
        conv_finish(CV_ITEM(j), F.lane, va); conv_load(CV_ITEM(j + 4), F.lane, va);
        conv_finish(CV_ITEM(j + 1), F.lane, vb); conv_load(CV_ITEM(j + 5), F.lane, vb);
        conv_finish(CV_ITEM(j + 2), F.lane, vc); conv_load(CV_ITEM(j + 6), F.lane, vc);
        conv_finish(CV_ITEM(j + 3), F.lane, vd); conv_load(CV_ITEM(j + 7), F.lane, vd);
    }
#undef CV_ITEM
}
#ifndef DEFER_CONV
#define DEFER_CONV (RET_FP8 && RO_FP8)
#endif
__device__ __forceinline__ void prologue_phase(const Frame& F0, const Args& a) {
    const Frame F = relaunder(F0);
    LAS float* scr = (LAS float*)(F.lds + F.wave * 16384);
    const int gw = F.vcu * 8 + F.wave, NGW = F.G * 8;
    constexpr int I0 = 2 * 16 * 96, I1 = 2 * 16 * 32, I2 = 2 * 16 * 192, I3 = 2 * 32 * 32, I4 = 128 * 16 * 64, I5 = 128 * 16 * 32;
    constexpr int NITEMS = I0 + I1 + I2 + I3 + I4 + I5;
    for (int it = gw; it < (DEFER_CONV ? I0 + I1 : NITEMS); it += NGW) {
        int r = it;
        if (r < I0) { const int per = 16 * 96, mi = r / per; if (QKV_FP8) transpose_item_fp8(a.diff_w_in + (size_t)mi * 1024 * 3072, 1024, 3072, a.ws + WS_WDI + (size_t)mi * 3072 * 1024, WRI_SCALE, scr, r % per, F.lane); else transpose_item(a.diff_w_in + (size_t)mi * 1024 * 3072, 1024, 3072, (bf16*)(a.ws + WS_WDI) + (size_t)mi * 3072 * 1024, scr, r % per, F.lane); continue; } r -= I0;
        if (r < I1) { const int per = 16 * 32, mi = r / per; if (DO_FP8) transpose_item_fp8(a.diff_w_out + (size_t)mi * 1024 * 1024, 1024, 1024, a.ws + WS_WDO + (size_t)mi * 1024 * 1024, WDO_SCALE, scr, r % per, F.lane); else transpose_item(a.diff_w_out + (size_t)mi * 1024 * 1024, 1024, 1024, (bf16*)(a.ws + WS_WDO) + (size_t)mi * 1024 * 1024, scr, r % per, F.lane); continue; } r -= I1;
        if (r < I2) { const int per = 16 * 192, mi = r / per; if (RET_FP8) transpose_item_fp8(a.ret_w_in + (size_t)mi * 1024 * 6144, 1024, 6144, a.ws + WS_WRI + (size_t)mi * 6144 * 1024, WRI_SCALE, scr, r % per, F.lane);
            else transpose_item(a.ret_w_in + (size_t)mi * 1024 * 6144, 1024, 6144, (bf16*)(a.ws + WS_WRI) + (size_t)mi * 6144 * 1024, scr, r % per, F.lane); continue; } r -= I2;
        if (r < I3) { const int per = 32 * 32, mi = r / per; if (RO_FP8) transpose_item_fp8(a.ret_w_out + (size_t)mi * 2048 * 1024, 2048, 1024, a.ws + WS_WRO + (size_t)mi * 1024 * 2048, WRO_SCALE, scr, r % per, F.lane); else transpose_item(a.ret_w_out + (size_t)mi * 2048 * 1024, 2048, 1024, (bf16*)(a.ws + WS_WRO) + (size_t)mi * 1024 * 2048, scr, r % per, F.lane); continue; } r -= I3;
        if (r < I4) { const int per = 16 * 64, mi = r / per; transpose_item_fp8(a.moe_w1 + (size_t)mi * 1024 * 2048, 1024, 2048, a.ws + WS_W1 + (size_t)mi * 2048 * 1024, W1_SCALE, scr, r % per, F.lane); continue; } r -= I4;
        { const int per = 16 * 32, mi = r / per; transpose_item_fp8(a.moe_w2 + (size_t)mi * 1024 * 1024, 1024, 1024, a.ws + WS_W2 + (size_t)mi * 1024 * 1024, W2_SCALE, scr, r % per, F.lane); }
    }
    { bf16* wg = (bf16*)(a.ws + WS_WRT);
      for (int idx = gw * 64 + F.lane; idx < DEPTH * DM * NEXP; idx += NGW * 64) { const int l = idx >> 15, r = idx & 32767, e = r & 31, k = r >> 5;
          const float w = ((const GAS float*)a.moe_rw)[idx] * ((const GAS float*)a.moe_norm)[l * DM + k];
          const unsigned hi = cvtpk(w, 0.f) & 0xffffu; const unsigned lo = cvtpk(w - __uint_as_float(hi << 16), 0.f) & 0xffffu;
          ((GAS bf16*)wg)[(size_t)l * (2 * NEXP * WRP) + e * WRP + k] = (bf16)hi; ((GAS bf16*)wg)[(size_t)l * (2 * NEXP * WRP) + NEXP * WRP + e * WRP + k] = (bf16)lo; } }
    f32x4 g[4]; load_row(a.diff_norm, F.lane, g);
    bf16* HB = (bf16*)(a.ws + WS_HB);
    for (int m = gw; m < NTOK; m += NGW) { f32x4 v[4], h[4]; { const GAS f32x4* px_ = (const GAS f32x4*)(a.x + (size_t)m * DM) + F.lane;
#pragma unroll
        for (int j = 0; j < 4; ++j) v[j] = __builtin_nontemporal_load(px_ + 64 * j); }
        rms_row(v, g, h);
        if (QKV_FP8) { GAS unsigned* o8 = (GAS unsigned*)(a.ws + WS_HB8 + (size_t)m * DM) + F.lane;
#pragma unroll
            for (int j = 0; j < 4; ++j) o8[64 * j] = pg8::pack_fp8x4(h[j][0] * H8_SCALE, h[j][1] * H8_SCALE, h[j][2] * H8_SCALE, h[j][3] * H8_SCALE); }
        else store_row_bf16(HB + (size_t)m * DM, F.lane, h);
        { GAS v2u* o_ = (GAS v2u*)((bf16*)(a.ws + WS_XB) + (size_t)m * DM) + F.lane;
#pragma unroll
          for (int j = 0; j < 4; ++j) { v2u w; w.x = cvtpk(v[j][0], v[j][1]); w.y = cvtpk(v[j][2], v[j][3]); __builtin_nontemporal_store(w, o_ + 64 * j); } } }
}

__device__ __forceinline__ void compute_toff(const Frame& F, const int* cnt) {
    if (opaque_tid() == 0) { int acc = 0;
        for (int e = 0; e < NEXP; ++e) { const int c_ = ((const GAS int*)cnt)[e]; F.misc[MI_TOFF + e] = acc; F.misc[MI_TOFF + 128 + e] = c_; acc += (c_ + 255) >> 8; }
        F.misc[MI_TOFF + 32] = acc; }
    __syncthreads();
    { LAS unsigned char* texp = (LAS unsigned char*)F.misc + 4 * MI_STG; const int TM = F.misc[MI_TOFF + 32];
      for (int t = opaque_tid(); t < TM; t += 512) { int e = 0;
#pragma unroll
          for (int k = 1; k < 32; ++k) e += (F.misc[MI_TOFF + k] <= t) ? 1 : 0;
          texp[t] = (unsigned char)e; } }
    __syncthreads();
}

__device__ __forceinline__ void tb_phase(const Frame& F0, const Args& a, int layer) {
    const Frame F = relaunder(F0);
    const float* rb = a.moe_rb + layer * NEXP;
    int* gcnt = (int*)(a.ws + WS_CTL) + CW_CNT + layer * NEXP;
    int* list = (int*)(a.ws + WS_LIST); int* tslot = (int*)(a.ws + WS_TSLOT); float* tgate = (float*)(a.ws + WS_TGATE); float* lrs = (float*)(a.ws + WS_LRS);
    unsigned char* HB8 = a.ws + WS_HB8;
    LAS bf16* WrT = (LAS bf16*)F.lds;
    { const GAS v4u* src = (const GAS v4u*)((const bf16*)(a.ws + WS_WRT) + (size_t)layer * (2 * NEXP * WRP));
      constexpr int NV = 2 * NEXP * WRP / 8, NFULL = NV / 512;
      v4u t_[NFULL];
#pragma unroll
      for (int i = 0; i < NFULL; ++i) t_[i] = src[F.tid + 512 * i];
      v4u tail_ = {0u, 0u, 0u, 0u}; if (F.tid < NV - 512 * NFULL) tail_ = src[512 * NFULL + F.tid];
#pragma unroll
      for (int i = 0; i < NFULL; ++i) ((LAS v4u*)WrT)[F.tid + 512 * i] = t_[i];
      if (F.tid < NV - 512 * NFULL) ((LAS v4u*)WrT)[512 * NFULL + F.tid] = tail_; }
    LAS int* lcnt = F.misc + MI_LCNT; LAS int* lbase = F.misc + MI_LBASE;
    LAS float* scr = (LAS float*)(F.lds + (F.wave < 6 ? 2 * NEXP * WRP * 2 + 2048 * F.wave : MISC_OFF + 12288 + 2048 * (F.wave - 6)));
    LAS unsigned* st_ep = (LAS unsigned*)(F.misc + MI_STEP); LAS float* st_g = (LAS float*)(F.misc + MI_STG); LAS float* st_r = (LAS float*)(F.misc + MI_STR);
    const int e_me = F.lane & 31, hsel = F.lane >> 5, r16 = F.lane & 15, kq = F.lane >> 4;
    const float bv0 = ((const GAS float*)rb)[r16], bv1 = ((const GAS float*)rb)[16 + r16];
    for (int bt = F.vcu; bt < NTOK / 256; bt += F.G) {
        if (F.tid < 32) lcnt[F.tid] = 0;
        __syncthreads();
#pragma unroll 1
        for (int gi = 0; gi < 2; ++gi) {
            const int rl0 = F.wave * 32 + 16 * gi; const size_t row = (size_t)bt * 256 + rl0 + r16;
            const GAS v4u* dp = (const GAS v4u*)(a.ws + WS_XB + (row * DM + 16 * kq) * 2);
            GAS v4u* op = (GAS v4u*)(HB8 + row * DM + 16 * kq);
            const LAS bf16* wp = WrT + r16 * WRP + 16 * kq;
            const GAS f32x4* gp = (const GAS f32x4*)(a.moe_norm + (size_t)layer * DM + 16 * kq);
            f32x4 acc0 = {0.f, 0.f, 0.f, 0.f}, acc1 = {0.f, 0.f, 0.f, 0.f}; float ss = 0.f;
            v4u da[2], db[2];
            da[0] = dp[0]; da[1] = dp[1]; db[0] = dp[8]; db[1] = dp[9];
#define TB_STEP(dc, T_) do { const int T = (T_); f32x4 v[4]; \
                v[0] = (f32x4){bflo(dc[0].x), bfhi(dc[0].x), bflo(dc[0].y), bfhi(dc[0].y)}; \
                v[1] = (f32x4){bflo(dc[0].z), bfhi(dc[0].z), bflo(dc[0].w), bfhi(dc[0].w)}; \
                v[2] = (f32x4){bflo(dc[1].x), bfhi(dc[1].x), bflo(dc[1].y), bfhi(dc[1].y)}; \
                v[3] = (f32x4){bflo(dc[1].z), bfhi(dc[1].z), bflo(dc[1].w), bfhi(dc[1].w)}; \
                _Pragma("unroll") for (int z = 0; z < 4; ++z) ss += (v[z][0] * v[z][0] + v[z][1] * v[z][1]) + (v[z][2] * v[z][2] + v[z][3] * v[z][3]); \
                _Pragma("unroll") for (int z = 0; z < 4; ++z) v[z] = v[z] * gp[16 * T + z]; \
                const bf16x8 a0 = __builtin_bit_cast(bf16x8, dc[0]), a1 = __builtin_bit_cast(bf16x8, dc[1]);     \
                { const int Tn = T + 2 < 16 ? T + 2 : T; \
                  dc[0] = dp[8 * Tn]; dc[1] = dp[8 * Tn + 1]; } \
                v4u o; \
                o.x = pg8::pack_fp8x4(v[0][0] * H8U_SCALE, v[0][1] * H8U_SCALE, v[0][2] * H8U_SCALE, v[0][3] * H8U_SCALE); \
                o.y = pg8::pack_fp8x4(v[1][0] * H8U_SCALE, v[1][1] * H8U_SCALE, v[1][2] * H8U_SCALE, v[1][3] * H8U_SCALE); \
                o.z = pg8::pack_fp8x4(v[2][0] * H8U_SCALE, v[2][1] * H8U_SCALE, v[2][2] * H8U_SCALE, v[2][3] * H8U_SCALE); \
                o.w = pg8::pack_fp8x4(v[3][0] * H8U_SCALE, v[3][1] * H8U_SCALE, v[3][2] * H8U_SCALE, v[3][3] * H8U_SCALE); \
                op[4 * T] = o; \
                _Pragma("unroll") for (int s_ = 0; s_ < 2; ++s_) { const bf16x8 av = s_ ? a1 : a0; const LAS bf16* w_ = wp + 64 * T + 8 * s_; \
                    acc0 = __builtin_amdgcn_mfma_f32_16x16x32_bf16(av, *(const LAS bf16x8*)(w_), acc0, 0, 0, 0); \
                    acc1 = __builtin_amdgcn_mfma_f32_16x16x32_bf16(av, *(const LAS bf16x8*)(w_ + 16 * WRP), acc1, 0, 0, 0); \
                    acc0 = __builtin_amdgcn_mfma_f32_16x16x32_bf16(av, *(const LAS bf16x8*)(w_ + NEXP * WRP), acc0, 0, 0, 0); \
                    acc1 = __builtin_amdgcn_mfma_f32_16x16x32_bf16(av, *(const LAS bf16x8*)(w_ + NEXP * WRP + 16 * WRP), acc1, 0, 0, 0); } } while (0)
#pragma unroll 1
            for (int T2 = 0; T2 < 8; ++T2) { TB_STEP(da, 2 * T2); TB_STEP(db, 2 * T2 + 1); }
#undef TB_STEP
            { const int l_ = lane_now(); ss += shfl_xor_(ss, 16, l_); ss += shfl_xor_(ss, 32, l_); }
            const float rstd = 1.0f / sqrtf(ss * (1.0f / DM) + NORM_EPS);
            if (F.lane < 16) st_r[rl0 + F.lane] = rstd;
#pragma unroll
            for (int i = 0; i < 4; ++i) { const float ri = shfl_idx_(rstd, 4 * kq + i);
                scr[(4 * kq + i) * 32 + r16] = acc0[i] * ri + bv0; scr[(4 * kq + i) * 32 + 16 + r16] = acc1[i] * ri + bv1; }
            asm volatile("s_waitcnt lgkmcnt(0)" ::: "memory");
#pragma unroll 1
            for (int it = 0; it < 8; ++it) {
                const int rowl = rl0 + 2 * it;
                const LAS float* lrow = scr + (2 * it + hsel) * 32;
                const float val = lrow[e_me];
                int rank = 0;
#pragma unroll
                for (int q = 0; q < 8; ++q) { const f32x4 t = *(const LAS f32x4*)(lrow + 4 * q);
#pragma unroll
                    for (int z = 0; z < 4; ++z) { const int ee = 4 * q + z; rank += (t[z] > val || (t[z] == val && ee < e_me)) ? 1 : 0; } }
                float vA[4], vB[4]; int eA[4], eB[4];
#pragma unroll
                for (int k = 0; k < 4; ++k) { const unsigned long long mk = __ballot(rank == k);
                    const int la = __builtin_amdgcn_readfirstlane(__builtin_ctz((unsigned)(mk & 0xffffffffull) | 0x80000000u));
                    const int lb = __builtin_amdgcn_readfirstlane(__builtin_ctz((unsigned)(mk >> 32) | 0x80000000u));
                    eA[k] = la; eB[k] = lb;
                    vA[k] = __uint_as_float(__builtin_amdgcn_readlane(__float_as_uint(val), la)); vB[k] = __uint_as_float(__builtin_amdgcn_readlane(__float_as_uint(val), 32 + lb)); }
                float gA[4], gB[4]; float sA = 0.f, sB = 0.f;
#pragma unroll
                for (int k = 0; k < 4; ++k) { gA[k] = __expf(vA[k] - vA[0]); gB[k] = __expf(vB[k] - vB[0]); sA += gA[k]; sB += gB[k]; }
                if (F.lane < 8) { const int r = F.lane >> 2, k = F.lane & 3;
                    const int e0 = r ? eB[0] : eA[0], e1 = r ? eB[1] : eA[1], e2 = r ? eB[2] : eA[2], e3 = r ? eB[3] : eA[3];
                    const float g0 = r ? gB[0] : gA[0], g1 = r ? gB[1] : gA[1], g2 = r ? gB[2] : gA[2], g3 = r ? gB[3] : gA[3];
                    const int e_ = k == 0 ? e0 : (k == 1 ? e1 : (k == 2 ? e2 : e3)); const float g_ = (k == 0 ? g0 : (k == 1 ? g1 : (k == 2 ? g2 : g3))) / (r ? sB : sA);
                    const int pl = atomicAdd((int*)(lcnt + e_), 1);
                    st_ep[(rowl + r) * 4 + k] = (unsigned)e_ | ((unsigned)pl << 8); st_g[(rowl + r) * 4 + k] = g_; }
            }
        }
        __syncthreads();
        if (F.tid < 32) lbase[F.tid] = atomicAdd(gcnt + F.tid, lcnt[F.tid]);
        __syncthreads();
        for (int idx = F.tid; idx < 1024; idx += 512) { const int rowl = idx >> 2, k = idx & 3; const unsigned ep = st_ep[idx]; const int e = (int)(ep & 255u); const int pos = lbase[e] + (int)(ep >> 8);
            const int tok = bt * 256 + rowl; ((GAS int*)list)[(size_t)e * NTOK + pos] = tok; ((GAS float*)lrs)[(size_t)e * NTOK + pos] = st_r[rowl]; ((GAS int*)tslot)[tok * 4 + k] = (e << 20) | pos; ((GAS float*)tgate)[tok * 4 + k] = st_g[idx]; }
        __syncthreads();
    }
}

__device__ __forceinline__ void tc_phase(const Frame& F0, const Args& a, bool last  , const float* gain  , bool h8, bool dry = false) {
    const Frame F = relaunder(F0);
    const int* tslot = (const int*)(a.ws + WS_TSLOT); const float* tgate = (const float*)(a.ws + WS_TGATE);
    const bf16* Y = (const bf16*)(a.ws + WS_Y); bf16* HB = (bf16*)(a.ws + WS_HB);
    f32x4 g[4];
    if (gain) load_row(gain, F.lane, g);
    const int gw = F.vcu * 8 + F.wave, NGW = F.G * 8;
    for (int m = gw; m < NTOK; m += NGW) {
        f32x4 v[4];
        { const GAS v2u* dr = (const GAS v2u*)(a.ws + WS_XB + (size_t)m * DM * 2) + F.lane;
#pragma unroll
          for (int j = 0; j < 4; ++j) { const v2u w = dr[64 * j]; v[j][0] = bflo(w.x); v[j][1] = bfhi(w.x); v[j][2] = bflo(w.y); v[j][3] = bfhi(w.y); } }
#pragma unroll
        for (int k = 0; k < 4; ++k) { const int ts = ((const GAS int*)tslot)[m * 4 + k]; const float gt = ((const GAS float*)tgate)[m * 4 + k]; const int e = ts >> 20, pos = ts & 0xfffff;
            const size_t slot = (size_t)F.misc[MI_TOFF + e] * 256 + pos;
            if (Y_FP8) { const GAS int* yr = (const GAS int*)((const unsigned char*)Y + slot * DM) + F.lane; const float g8 = gt * (1.0f / Y8_SCALE);
#pragma unroll
                for (int j = 0; j < 4; ++j) { const int w = __builtin_nontemporal_load(yr + 64 * j); const f32x2 lo = __builtin_amdgcn_cvt_pk_f32_fp8(w, false), hi = __builtin_amdgcn_cvt_pk_f32_fp8(w, true);
                    v[j][0] += g8 * lo.x; v[j][1] += g8 * lo.y; v[j][2] += g8 * hi.x; v[j][3] += g8 * hi.y; } }
            else { const GAS v2u* yr = (const GAS v2u*)(Y + slot * DM) + F.lane;
#pragma unroll
                for (int j = 0; j < 4; ++j) { const v2u w = yr[64 * j]; v[j][0] += gt * bflo(w.x); v[j][1] += gt * bfhi(w.x); v[j][2] += gt * bflo(w.y); v[j][3] += gt * bfhi(w.y); } } }
        if (!dry) {
            if (last) { GAS f32x4* o = (GAS f32x4*)(a.out + (size_t)m * DM) + F.lane;
#pragma unroll
                for (int j = 0; j < 4; ++j) __builtin_nontemporal_store(v[j], o + 64 * j); }
            else store_row_bf16((bf16*)(a.ws + WS_XB) + (size_t)m * DM, F.lane, v); }
        if (gain) { f32x4 h[4]; rms_row(v, g, h);
            if (h8) { GAS unsigned* o8 = (GAS unsigned*)(a.ws + WS_HB8 + (size_t)m * DM) + F.lane;
#pragma unroll
                for (int j = 0; j < 4; ++j) o8[64 * j] = pg8::pack_fp8x4(h[j][0] * H8_SCALE, h[j][1] * H8_SCALE, h[j][2] * H8_SCALE, h[j][3] * H8_SCALE); }
            else store_row_bf16(HB + (size_t)m * DM, F.lane, h); }
    }
}

__device__ __forceinline__ void td_phase(const Frame& F0, const Args& a) {
    const Frame F = relaunder(F0);
    const bf16* OF = (const bf16*)(a.ws + WS_ROF); const bf16* OB = (const bf16*)(a.ws + WS_ROB); const bf16* RG = (const bf16*)(a.ws + WS_PROJ + 640 * MiB); bf16* GO = (bf16*)(a.ws + WS_RGO);
    const int gw = F.vcu * 8 + F.wave, NGW = F.G * 8;
    for (int m = gw; m < NTOK; m += NGW) {
#pragma unroll
        for (int hd = 0; hd < 4; ++hd) { const size_t off = (size_t)m * 2048 + hd * 512 + 8 * F.lane;
            const v4u f = __builtin_nontemporal_load((const GAS v4u*)(OF + off)), b = __builtin_nontemporal_load((const GAS v4u*)(OB + off)), gg = __builtin_nontemporal_load((const GAS v4u*)(RG + off));
            float o[8]; o[0] = bflo(f.x) + bflo(b.x); o[1] = bfhi(f.x) + bfhi(b.x); o[2] = bflo(f.y) + bflo(b.y); o[3] = bfhi(f.y) + bfhi(b.y);
            o[4] = bflo(f.z) + bflo(b.z); o[5] = bfhi(f.z) + bfhi(b.z); o[6] = bflo(f.w) + bflo(b.w); o[7] = bfhi(f.w) + bfhi(b.w);
            float s = 0.f;
#pragma unroll
            for (int i = 0; i < 8; ++i) s += o[i] * o[i];
            const float rstd = 1.0f / sqrtf(wave_sum(s) * (1.0f / 512.0f) + NORM_EPS);
            float gv[8]; gv[0] = bflo(gg.x); gv[1] = bfhi(gg.x); gv[2] = bflo(gg.y); gv[3] = bfhi(gg.y); gv[4] = bflo(gg.z); gv[5] = bfhi(gg.z); gv[6] = bflo(gg.w); gv[7] = bfhi(gg.w);
#pragma unroll
            for (int i = 0; i < 8; ++i) { const float sg = gv[i] * __builtin_amdgcn_rcpf(1.0f + __builtin_amdgcn_exp2f(-LOG2E * gv[i])); o[i] = o[i] * rstd * sg; }
            if (RO_FP8) { v2u w; w.x = pg8::pack_fp8x4(o[0] * GO8_SCALE, o[1] * GO8_SCALE, o[2] * GO8_SCALE, o[3] * GO8_SCALE); w.y = pg8::pack_fp8x4(o[4] * GO8_SCALE, o[5] * GO8_SCALE, o[6] * GO8_SCALE, o[7] * GO8_SCALE);
                *(GAS v2u*)((unsigned char*)GO + off) = w; }
            else { v4u w; w.x = cvtpk(o[0], o[1]); w.y = cvtpk(o[2], o[3]); w.z = cvtpk(o[4], o[5]); w.w = cvtpk(o[6], o[7]);
                *(GAS v4u*)(GO + off) = w; } }
    }
}

constexpr int N_PHASES = 1 + 9 * DEPTH;
#ifndef MOE_ALIGN
#define MOE_ALIGN true
#endif
__global__ void __launch_bounds__(512, 2) fwd_kernel(Args a) {
    static_assert(WTAB_BYTES == MISC_OFF + 4 * 192, "wave table location");
    static_assert(pg8::TEXP_REL == 4 * MI_STG - 4 * MI_TOFF && pg8::PARK_OFF == MISC_OFF + 12288 && pg8::LISTPARK_OFF == MISC_OFF + 4 * MI_STEP, "park buffers");
    Frame F;
    F.lds = (LAS unsigned char*)lds_raw; F.misc = (LAS int*)(F.lds + MISC_OFF);
    F.tid = threadIdx.x; F.lane = F.tid & 63; F.wave = __builtin_amdgcn_readfirstlane(F.tid >> 6);
    F.G = gridDim.x; { const int bx = blockIdx.x; F.vcu = (F.G % 8 == 0) ? (bx % 8) * (F.G / 8) + bx / 8 : bx; }
    for (int u = F.tid; u < (LDS_BYTES - MISC_OFF) / 4; u += 512) F.misc[u] = 0;
    __syncthreads();
    if (F.lane == 0) F.misc[192 + hw_wave_slot()] = F.wave;
    __syncthreads();
    unsigned* barw = (unsigned*)(a.ws + WS_CTL) + CW_BAR;
    const int lo = a.ph_lo, hi = a.ph_hi;
    XcdBarrier bar; bar.bar = barw; bar.x = 0; bar.st = nullptr;
    if (hi - lo > 1) bar = xcd_barrier_post(barw, (volatile LAS unsigned*)F.misc);
#ifndef PH_MASK
#define PH_MASK 0xffff
#endif
#define PHM(b) ((PH_MASK >> (b)) & 1)
#ifndef REP_MASK
#define REP_MASK 0
#endif
#define REPS(b) ((((REP_MASK) >> (b)) & 1) ? 2 : 1)
#define RUN(k) (lo <= (k) && (k) < hi)
#ifdef BAR_TWICE
#define AFTER(k) do { if ((k) + 1 < hi) { xcd_barrier(bar); xcd_barrier(bar); } } while (0)
#else
#define AFTER(k) do { if ((k) + 1 < hi) xcd_barrier(bar); } while (0)
#endif
    unsigned char* ws = a.ws;
    bf16* HB;
    if (PHM(0) && RUN(0)) { for (int rep_ = 0; rep_ < REPS(0); ++rep_) { if (rep_) xcd_barrier(bar); prologue_phase(F, a); } AFTER(0); }
#pragma unroll 1
    for (int i = 0; i < DEPTH; ++i) {
        const int pb = 1 + 9 * i, jl = i >> 1;
        ws = opaque_ptr(ws); HB = (bf16*)(ws + WS_HB);
        if ((i & 1) == 0) {
            bf16* Qb = (bf16*)(ws + WS_PROJ); bf16* Kb = (bf16*)(ws + WS_PROJ + 128 * MiB); bf16* Vb = (bf16*)(ws + WS_PROJ + 256 * MiB); bf16* AO = (bf16*)(ws + WS_AO);
            if (PHM(1) && RUN(pb + 0)) { for (int rep_ = 0; rep_ < REPS(1); ++rep_) { if (rep_) xcd_barrier(bar);
                pg8::DenseProb<1024, 2, QKV_FP8 != 0> P{QKV_FP8 ? (const void*)(ws + WS_HB8) : (const void*)HB, QKV_FP8 ? (const void*)(ws + WS_WDI + (size_t)jl * 3072 * 1024) : (const void*)((const bf16*)(ws + WS_WDI) + (size_t)jl * 3072 * 1024), NTOK / 256, 12, F.G, F.vcu};
                pg8::EpiQKV E{Qb, Kb, Vb, a.qn + jl * 64, a.kn + jl * 64, QKV_FP8 ? 1.0f / (H8_SCALE * WRI_SCALE) : 1.0f};
                pg8::gemm_phase<pg8::DenseProb<1024, 2, QKV_FP8 != 0>, pg8::EpiQKV, true>(F.lds, P, E);
                } AFTER(pb + 0);
            }
            if (PHM(2) && RUN(pb + 2)) { for (int rep_ = 0; rep_ < REPS(2); ++rep_) { if (rep_) xcd_barrier(bar);
                const int ln_ = lane_now();
                float s1 = ((const GAS float*)a.lq1)[jl * 64 + ln_] * ((const GAS float*)a.lk1)[jl * 64 + ln_], s2 = ((const GAS float*)a.lq2)[jl * 64 + ln_] * ((const GAS float*)a.lk2)[jl * 64 + ln_];
                s1 = wave_sum(s1); s2 = wave_sum(s2);
                const float linit = 0.8f - 0.6f * expf(-0.3f * (float)i);
                float gq = fabsf(((const GAS float*)a.qn)[jl * 64 + ln_]), gk = fabsf(((const GAS float*)a.kn)[jl * 64 + ln_]);
#pragma unroll
                for (int o_ = 1; o_ < 64; o_ <<= 1) { gq = fmaxf(gq, shfl_xor_(gq, o_, ln_)); gk = fmaxf(gk, shfl_xor_(gk, o_, ln_)); }
                const float lam_u = __uint_as_float(__builtin_amdgcn_readfirstlane(__float_as_uint(expf(s1) - expf(s2) + linit)));
                att::AttnArgs A{Qb, Kb, Vb, AO, lam_u, a.subln + jl * 128, 1.0f - linit, 8.1f * gq * gk};
                for (int u = F.vcu; u < NBATCH * 8 * 16; u += F.G) { const int bq = u % (NBATCH * 16), h = u / (NBATCH * 16); att::attn_unit(bq >> 4, h, h == 3 ? ((bq + 8) & 15) : (bq & 15), A, (LAS char*)F.lds);
                    if (DEFER_CONV && i == 0 && rep_ == 0 && h == 2 + (F.vcu % 5)) { deferred_conversion(F, a); } }
#ifdef ATT_TWICE
                xcd_barrier(bar);
                for (int u = F.vcu; u < NBATCH * 8 * 16; u += F.G) { const int bq = u % (NBATCH * 16), h = u / (NBATCH * 16); att::attn_unit(bq >> 4, h, h == 3 ? ((bq + 8) & 15) : (bq & 15), A, (LAS char*)F.lds); }
#endif
                } AFTER(pb + 2);
            }
            if (PHM(3) && RUN(pb + 4)) {
                pg8::DenseProb<1024, 1, DO_FP8 != 0> P{AO, DO_FP8 ? (const void*)(ws + WS_WDO + (size_t)jl * 1024 * 1024) : (const void*)((const bf16*)(ws + WS_WDO) + (size_t)jl * 1024 * 1024), NTOK / 256, 4, F.G, F.vcu};
                pg8::EpiDelta E{(bf16*)(ws + WS_XB), DO_FP8 ? 1.0f / (AO8_SCALE * WDO_SCALE) : 1.0f};
                pg8::gemm_phase<pg8::DenseProb<1024, 1, DO_FP8 != 0>, pg8::EpiDelta, true>(F.lds, P, E);
                AFTER(pb + 4);
            }
        } else {
            bf16* RQ = (bf16*)(ws + WS_PROJ); bf16* RKF = (bf16*)(ws + WS_PROJ + 128 * MiB); bf16* RKB = (bf16*)(ws + WS_PROJ + 256 * MiB); bf16* RV = (bf16*)(ws + WS_PROJ + 384 * MiB); bf16* RG = (bf16*)(ws + WS_PROJ + 640 * MiB);
            bf16* RP = (bf16*)(ws + WS_RP);
            if (PHM(4) && RUN(pb + 0)) { for (int rep_ = 0; rep_ < REPS(4); ++rep_) { if (rep_) xcd_barrier(bar);
                pg8::DenseProb<1024, 1, RET_FP8 != 0> P{RET_FP8 ? (const void*)(ws + WS_HB8) : (const void*)HB, RET_FP8 ? (const void*)(ws + WS_WRI + (size_t)jl * 6144 * 1024) : (const void*)((const bf16*)(ws + WS_WRI) + (size_t)jl * 6144 * 1024), NTOK / 256, 24, F.G, F.vcu};
                pg8::EpiRetIn E{RQ, RKF, RKB, RV, RG, a.lgf + jl * 4, a.lgb + jl * 4, RET_FP8 ? 1.0f / (H8_SCALE * WRI_SCALE) : 1.0f};
                pg8::gemm_phase<pg8::DenseProb<1024, 1, RET_FP8 != 0>, pg8::EpiRetIn, true>(F.lds, P, E);
                } AFTER(pb + 0);
            }
            if (PHM(5) && RUN(pb + 1)) { for (int rep_ = 0; rep_ < REPS(5); ++rep_) { if (rep_) xcd_barrier(bar);
                const int gw = F.vcu * 8 + F.wave, NGW = F.G * 8;
                for (int u = gw; u < NBATCH * 4 * 128; u += NGW) { const int sc = u & 127, h = (u >> 7) & 3, b = u >> 9; ret::rp_unit(b, h, sc, RQ, RKF, RKB, RP, a.lgf[jl * 4 + h], a.lgb[jl * 4 + h]); }
                } AFTER(pb + 1);
            }
            if (PHM(6) && RUN(pb + 2)) { for (int rep_ = 0; rep_ < REPS(6); ++rep_) { if (rep_) xcd_barrier(bar);
                for (int u = F.vcu; u < NBATCH * 4 * 2 * 2; u += F.G) { const int vs = u & 1, dir = (u >> 1) & 1, h = (u >> 2) & 3, b = u >> 4;
                    ret::ChainArgs A{RQ, dir ? RKB : RKF, RV, RP, (bf16*)(ws + (dir ? WS_ROB : WS_ROF)), dir ? a.lgb[jl * 4 + h] : a.lgf[jl * 4 + h]};
                    ret::chain_unit(b, h, dir, vs, A, (LAS char*)F.lds); }
                } AFTER(pb + 2);
            }
            if (PHM(7) && RUN(pb + 3)) { for (int rep_ = 0; rep_ < REPS(7); ++rep_) { if (rep_) xcd_barrier(bar); td_phase(F, a); } AFTER(pb + 3); }
            if (PHM(8) && RUN(pb + 4)) {
                pg8::DenseProb<2048, 1, RO_FP8 != 0> P{(const void*)(ws + WS_RGO), RO_FP8 ? (const void*)(ws + WS_WRO + (size_t)jl * 1024 * 2048) : (const void*)((const bf16*)(ws + WS_WRO) + (size_t)jl * 1024 * 2048), NTOK / 256, 4, F.G, F.vcu};
                pg8::EpiDelta E{(bf16*)(ws + WS_XB), RO_FP8 ? 1.0f / (GO8_SCALE * WRO_SCALE) : 1.0f};
                pg8::gemm_phase<pg8::DenseProb<2048, 1, RO_FP8 != 0>, pg8::EpiDelta, true>(F.lds, P, E);
                AFTER(pb + 4);
            }
        }
        const int* cnt = (const int*)(ws + WS_CTL) + CW_CNT + i * NEXP;
        if (PHM(9) && RUN(pb + 5)) {
            if (REPS(9) == 2) { tb_phase(F, a, i); xcd_barrier(bar); { const int t_ = opaque_tid(); if (blockIdx.x == 0 && t_ < NEXP) ((GAS int*)(ws + WS_CTL))[CW_CNT + i * NEXP + t_] = 0; } xcd_barrier(bar); }
            tb_phase(F, a, i); AFTER(pb + 5); }
        if (PHM(10) && RUN(pb + 6)) { for (int rep_ = 0; rep_ < REPS(10); ++rep_) { if (rep_) xcd_barrier(bar);
            compute_toff(F, cnt);
            pg8::MoeProb<1024, true, 3> P{ws + WS_HB8, ws + WS_W1 + (size_t)i * NEXP * 2048 * 1024, (size_t)2048 * 1024, (const int*)(ws + WS_LIST), cnt, F.misc + MI_TOFF, 8, F.G, F.vcu};
            pg8::EpiSwiglu E{ws + WS_ACT, a.moe_b1 + (size_t)i * NEXP * 2048, (const float*)(ws + WS_LRS), 1.0f / (H8U_SCALE * W1_SCALE)};
            pg8::gemm_phase<pg8::MoeProb<1024, true, 3>, pg8::EpiSwiglu, MOE_ALIGN>(F.lds, P, E);
            } AFTER(pb + 6);
        }
        if (PHM(11) && RUN(pb + 7)) { for (int rep_ = 0; rep_ < REPS(11); ++rep_) { if (rep_) xcd_barrier(bar);
            if (!(PHM(10) && RUN(pb + 6))) compute_toff(F, cnt);
            pg8::MoeProb<1024, false, 1> P{ws + WS_ACT, ws + WS_W2 + (size_t)i * NEXP * 1024 * 1024, (size_t)1024 * 1024, (const int*)(ws + WS_LIST), cnt, F.misc + MI_TOFF, 4, F.G, F.vcu};
            pg8::EpiBias E{(void*)(ws + WS_Y), a.moe_b2 + (size_t)i * NEXP * 1024, 1.0f / (W2_SCALE * ACT8_SCALE)};
            pg8::gemm_phase<pg8::MoeProb<1024, false, 1>, pg8::EpiBias, MOE_ALIGN>(F.lds, P, E);
            } AFTER(pb + 7);
        }
        if (PHM(12) && RUN(pb + 8)) {
            if (!(PHM(10) && RUN(pb + 6))) compute_toff(F, cnt);
            const float* gain = (i == DEPTH - 1) ? nullptr : ((i & 1) == 0 ? a.ret_norm + (size_t)jl * DM : a.diff_norm + (size_t)(jl + 1) * DM);
            if (REPS(12) == 2) { tc_phase(F, a, i == DEPTH - 1, gain, (i & 1) == 0 ? (RET_FP8 != 0) : (QKV_FP8 != 0), true); xcd_barrier(bar); }
            tc_phase(F, a, i == DEPTH - 1, gain, (i & 1) == 0 ? (RET_FP8 != 0) : (QKV_FP8 != 0));
            AFTER(pb + 8);
        }
    }
#undef RUN
#undef AFTER
}

#ifndef MK_PER_PHASE
#define MK_PER_PHASE 0
#endif
extern "C" void kernel_launch(void* const* d_in, const int* in_sizes, int n_in, void* d_out, int out_size, void* d_ws, size_t ws_size, hipStream_t stream) {
    static int grid = 0;
    if (grid == 0) {
        if (n_in != 23 || in_sizes[0] != NTOK * DM || out_size != NTOK * DM || ws_size < WS_END) { fprintf(stderr, "kernel_launch: unexpected shapes (n_in %d, in0 %d, out %d, ws %zu); nothing launched\n", n_in, n_in > 0 ? in_sizes[0] : -1, out_size, ws_size); grid = -1; return; }
        int dev = 0, cus = 0, per_cu = 0;
        if (hipGetDevice(&dev) != hipSuccess || hipDeviceGetAttribute(&cus, hipDeviceAttributeMultiprocessorCount, dev) != hipSuccess) { fprintf(stderr, "kernel_launch: device query failed\n"); grid = -1; return; }
        if (hipFuncSetAttribute((const void*)fwd_kernel, hipFuncAttributeMaxDynamicSharedMemorySize, LDS_BYTES) != hipSuccess) { fprintf(stderr, "kernel_launch: hipFuncSetAttribute failed\n"); grid = -1; return; }
        if (hipOccupancyMaxActiveBlocksPerMultiprocessor(&per_cu, (const void*)fwd_kernel, 512, LDS_BYTES) != hipSuccess || per_cu < 1) fprintf(stderr, "kernel_launch: note: occupancy query reports %d workgroups per CU\n", per_cu);
        (void)hipGetLastError();
        grid = cus;
    }
    if (grid < 0) return;
    if (hipMemsetAsync((char*)d_ws + WS_CTL, 0, CTL_ZERO_BYTES, stream) != hipSuccess) { fprintf(stderr, "kernel_launch: memset failed\n"); return; }
    Args a{};
    const float** ap = (const float**)&a;
    for (int i = 0; i < 23; ++i) ap[i] = (const float*)d_in[i];
    a.out = (float*)d_out; a.ws = (unsigned char*)d_ws;
#if MK_PER_PHASE
    for (int p = 0; p < N_PHASES; ++p) {
        if (p > 0) { const int i = (p - 1) / 9, k = (p - 1) % 9; if ((i & 1) == 0 && (k == 1 || k == 3)) continue; }
        a.ph_lo = p; a.ph_hi = p + 1;
        hipLaunchKernelGGL(fwd_kernel, dim3(grid), dim3(512), LDS_BYTES, stream, a);
    }
#else
    a.ph_lo = 0; a.ph_hi = N_PHASES;
    hipLaunchKernelGGL(fwd_kernel, dim3(grid), dim3(512), LDS_BYTES, stream, a);
#endif
    const hipError_t le = hipPeekAtLastError();
    if (le != hipSuccess) fprintf(stderr, "kernel_launch: launch failed: %s\n", hipGetErrorName(le));
}
```
